# Optimizing an MI355X kernel written in HIP

```python
import jax
import jax.numpy as jnp
from jax import lax
import numpy as np

D_MODEL = 2048
BATCH = 1
SEQ = 16384
DEPTH = 2

N_MIXERS = 2
GRID_W = 64
N_MEM = 256
RMS_EPS = 1e-6
GN_EPS = 1e-6

RET_HEADS = 8
RET_QK_DIM = D_MODEL // RET_HEADS
RET_V_DIM = 2 * D_MODEL // RET_HEADS
RET_CHUNK = 128
ROPE_BASE = 10000.0

NA_HEADS = 16
NA_HEAD_DIM = D_MODEL // NA_HEADS
NA_WIN_ROWS = 8
NA_WIN_COLS = 16

XA_HEADS = 4
XA_HEAD_DIM = 128
XA_INNER = XA_HEADS * XA_HEAD_DIM

FFN_DIM = 11 * D_MODEL // 4
N_EXPERTS = 8
MOE_TOP_K = 2
EXPERT_DIM = 7 * D_MODEL // 2
MOE_BLOCK = 128

N_EVEN = (DEPTH + 1) // 2
N_ODD = DEPTH // 2

kernel_name = 'hybrid_retention_natten_moe_encoder'


def _rms_norm(x, gain):
    xf = x.astype(jnp.float32)
    y = xf * lax.rsqrt(jnp.mean(xf * xf, axis=-1, keepdims=True) + RMS_EPS)
    return (y * gain.astype(jnp.float32)).astype(x.dtype)


def _rotary(x):
    s, d = x.shape[1], x.shape[-1]
    inv_freq = jnp.power(ROPE_BASE, -jnp.arange(0, d, 2, dtype=jnp.float32) / d)
    ang = jnp.arange(s, dtype=jnp.float32)[:, None] * inv_freq[None, :]
    cos = jnp.cos(ang)[None, :, None, :]
    sin = jnp.sin(ang)[None, :, None, :]
    x1, x2 = x[..., : d // 2], x[..., d // 2:]
    return jnp.concatenate([x1 * cos - x2 * sin, x2 * cos + x1 * sin], axis=-1)


def _retention_one_direction(q, k, v, log_decay, strict):
    b, s, h, dk = q.shape
    dv = v.shape[-1]
    c = RET_CHUNK
    nc = s // c
    idx = jnp.arange(c, dtype=jnp.float32)
    rel = idx[:, None] - idx[None, :]
    keep = (rel > 0) if strict else (rel >= 0)
    decay_in = jnp.where(keep[None], jnp.exp(log_decay[:, None, None] * jnp.maximum(rel, 0.0)[None]), 0.0)
    xi = jnp.exp(log_decay[:, None] * (idx + 1.0)[None])
    zeta = jnp.exp(log_decay[:, None] * (c - 1.0 - idx)[None])
    decay_chunk = jnp.exp(log_decay * c)

    def to_chunks(t):
        return t.reshape(b, nc, c, h, t.shape[-1]).transpose(1, 0, 3, 2, 4)

    def step(state, inp):
        qi, ki, vi = inp
        scores = jnp.einsum('bhqd,bhkd->bhqk', qi, ki) * decay_in
        inner = jnp.einsum('bhqk,bhkv->bhqv', scores, vi)
        cross = jnp.einsum('bhqd,bhdv->bhqv', qi * xi[None, :, :, None], state)
        state = decay_chunk[None, :, None, None] * state + jnp.einsum('bhkd,bhkv->bhdv', ki * zeta[None, :, :, None], vi)
        return state, inner + cross

    state0 = jnp.zeros((b, h, dk, dv), jnp.float32)
    _, out = lax.scan(step, state0, (to_chunks(q), to_chunks(k), to_chunks(v)))
    return out.transpose(1, 0, 3, 2, 4).reshape(b, s, h, dv)


def _retention_mixer(h, w_in, w_out, decay_logit, gn_gain):
    b, s, _ = h.shape
    qk_w = RET_HEADS * RET_QK_DIM
    v_w = RET_HEADS * RET_V_DIM
    proj = h @ w_in
    q = proj[..., :qk_w].astype(jnp.float32).reshape(b, s, RET_HEADS, RET_QK_DIM)
    k = proj[..., qk_w:2 * qk_w].astype(jnp.float32).reshape(b, s, RET_HEADS, RET_QK_DIM)
    v = proj[..., 2 * qk_w:2 * qk_w + v_w].astype(jnp.float32).reshape(b, s, RET_HEADS, RET_V_DIM)
    g = proj[..., 2 * qk_w + v_w:].astype(jnp.float32)
    q = _rotary(q)
    k = _rotary(k) * (RET_QK_DIM ** -0.5)
    log_decay = jax.nn.log_sigmoid(decay_logit.astype(jnp.float32))
    y_fwd = _retention_one_direction(q, k, v, log_decay[0], strict=False)
    y_bwd = jnp.flip(_retention_one_direction(jnp.flip(q, 1), jnp.flip(k, 1), jnp.flip(v, 1), log_decay[1], strict=True), 1)
    y = y_fwd + y_bwd
    mu = jnp.mean(y, axis=-1, keepdims=True)
    var = jnp.mean(jnp.square(y - mu), axis=-1, keepdims=True)
    y = ((y - mu) * lax.rsqrt(var + GN_EPS)).reshape(b, s, v_w) * gn_gain.astype(jnp.float32)
    y = jax.nn.silu(g) * y
    return y.astype(h.dtype) @ w_out


def _neighbourhood_attention(h, w_in, w_out, rpb):
    b, s, _ = h.shape
    rows = s // GRID_W
    wr = min(NA_WIN_ROWS, rows)
    wc = NA_WIN_COLS
    n_keys = wr * wc
    width = NA_HEADS * NA_HEAD_DIM
    qkv = h @ w_in
    q = qkv[..., :width].reshape(b, s, NA_HEADS, NA_HEAD_DIM)
    k = qkv[..., width:2 * width].reshape(b, s, NA_HEADS, NA_HEAD_DIM)
    v = qkv[..., 2 * width:].reshape(b, s, NA_HEADS, NA_HEAD_DIM)
    cols = jnp.arange(GRID_W)
    col_start = jnp.clip(cols - wc // 2, 0, GRID_W - wc)
    key_cols = col_start[:, None] + jnp.arange(wc)[None, :]
    dc = key_cols - cols[:, None]
    scale = NA_HEAD_DIM ** -0.5

    def row_block(r):
        row_start = jnp.clip(r - wr // 2, 0, rows - wr)
        key_rows = row_start + jnp.arange(wr)
        tok = (key_rows[None, :, None] * GRID_W + key_cols[:, None, :]).reshape(GRID_W, n_keys)
        dr = key_rows - r
        bias = rpb[:, dr[None, :, None] + NA_WIN_ROWS - 1, dc[:, None, :] + NA_WIN_COLS - 1]
        bias = bias.reshape(NA_HEADS, GRID_W, n_keys).astype(jnp.float32)
        q_blk = lax.dynamic_slice_in_dim(q, r * GRID_W, GRID_W, axis=1)
        k_blk = jnp.take(k, tok, axis=1)
        v_blk = jnp.take(v, tok, axis=1)
        scores = jnp.einsum('bqhd,bqkhd->bhqk', q_blk, k_blk).astype(jnp.float32) * scale + bias[None]
        p = jax.nn.softmax(scores, axis=-1)
        return jnp.einsum('bhqk,bqkhd->bqhd', p.astype(v.dtype), v_blk)

    out = lax.map(row_block, jnp.arange(rows))
    out = out.transpose(1, 0, 2, 3, 4).reshape(b, s, width)
    return out @ w_out


def _memory_cross_attention(h, mem_k, mem_v, w_q, w_out):
    b, s, _ = h.shape
    q = (h @ w_q).reshape(b, s, XA_HEADS, XA_HEAD_DIM)
    scores = jnp.einsum('bqhd,bkhd->bhqk', q, mem_k).astype(jnp.float32) * (XA_HEAD_DIM ** -0.5)
    p = jax.nn.softmax(scores, axis=-1)
    o = jnp.einsum('bhqk,bkhd->bqhd', p.astype(mem_v.dtype), mem_v)
    return o.reshape(b, s, XA_INNER) @ w_out


def _swiglu(h, w_gate, w_up, w_down):
    return (jax.nn.silu(h @ w_gate) * (h @ w_up)) @ w_down


def _moe_swiglu(h, w_router, w_gate, w_up, w_down):
    b, s, d = h.shape
    t = b * s
    xt = h.reshape(t, d)
    logits = (xt @ w_router).astype(jnp.float32)
    top_val, top_idx = lax.top_k(logits, MOE_TOP_K)
    gates = jax.nn.softmax(top_val, axis=-1)
    flat_e = top_idx.reshape(-1)
    flat_tok = jnp.repeat(jnp.arange(t, dtype=jnp.int32), MOE_TOP_K)
    flat_w = gates.reshape(-1)
    order = jnp.argsort(flat_e)
    se, stok, sw = flat_e[order], flat_tok[order], flat_w[order]
    counts = jnp.zeros((N_EXPERTS,), jnp.int32).at[flat_e].add(1)
    padded = ((counts + MOE_BLOCK - 1) // MOE_BLOCK) * MOE_BLOCK
    start = jnp.cumsum(counts) - counts
    pend = jnp.cumsum(padded)
    pstart = pend - padded
    n_assign = t * MOE_TOP_K
    pos = jnp.arange(n_assign) - start[se] + pstart[se]
    n_blocks = n_assign // MOE_BLOCK + N_EXPERTS
    n_pad = n_blocks * MOE_BLOCK
    buf_tok = jnp.zeros((n_pad,), jnp.int32).at[pos].set(stok)
    buf_w = jnp.zeros((n_pad,), jnp.float32).at[pos].set(sw)
    block_e = jnp.clip(jnp.searchsorted(pend, jnp.arange(n_blocks) * MOE_BLOCK, side='right'), 0, N_EXPERTS - 1)

    def expert_block(args):
        tok, wts, e = args
        xb = xt[tok]
        y = (jax.nn.silu(xb @ w_gate[e]) * (xb @ w_up[e])) @ w_down[e]
        return y * wts[:, None].astype(y.dtype)

    y = lax.map(expert_block, (buf_tok.reshape(n_blocks, MOE_BLOCK), buf_w.reshape(n_blocks, MOE_BLOCK), block_e))
    out = jnp.zeros((t, d), y.dtype).at[buf_tok].add(y.reshape(n_pad, d))
    return out.astype(h.dtype).reshape(b, s, d)


def setup_inputs(seed: int = 0) -> dict:
    key = jax.random.key(seed)
    ks = jax.random.split(key, 24)
    f32 = jnp.float32

    def w(k, shape, fan_in):
        return jax.random.normal(k, shape, f32) * (fan_in ** -0.5)

    def gain(k, shape):
        return 1.0 + 0.02 * jax.random.normal(k, shape, f32)

    ret_in_cols = 2 * RET_HEADS * RET_QK_DIM + 2 * RET_HEADS * RET_V_DIM
    ret_v = RET_HEADS * RET_V_DIM
    heads = jnp.arange(RET_HEADS, dtype=f32)
    base = jnp.stack([jnp.log(jnp.exp2(5.0 + heads) - 1.0), jnp.log(jnp.exp2(5.5 + heads) - 1.0)])
    ret_decay_logit = base[None] + 0.1 * jax.random.normal(ks[0], (N_EVEN, 2, RET_HEADS), f32)
    na_width = NA_HEADS * NA_HEAD_DIM

    x = jax.random.normal(ks[1], (BATCH, SEQ, D_MODEL), f32)
    mem = jax.random.normal(ks[2], (BATCH, N_MEM, D_MODEL), f32)
    mem_norm_gain = gain(ks[3], (D_MODEL,))
    mem_w_kv = w(ks[4], (D_MODEL, 2 * XA_INNER), D_MODEL)
    norm_gain = gain(ks[5], (DEPTH, 3, D_MODEL))
    ret_w_in = w(ks[6], (N_EVEN, D_MODEL, ret_in_cols), D_MODEL)
    ret_w_out = w(ks[7], (N_EVEN, ret_v, D_MODEL), ret_v)
    ret_gn_gain = gain(ks[8], (N_EVEN, ret_v))
    ffn_w_gate = w(ks[9], (N_EVEN, D_MODEL, FFN_DIM), D_MODEL)
    ffn_w_up = w(ks[10], (N_EVEN, D_MODEL, FFN_DIM), D_MODEL)
    ffn_w_down = w(ks[11], (N_EVEN, FFN_DIM, D_MODEL), FFN_DIM)
    na_w_in = w(ks[12], (N_ODD, D_MODEL, 3 * na_width), D_MODEL)
    na_w_out = w(ks[13], (N_ODD, na_width, D_MODEL), na_width)
    na_rpb = 0.1 * jax.random.normal(ks[14], (N_ODD, NA_HEADS, 2 * NA_WIN_ROWS - 1, 2 * NA_WIN_COLS - 1), f32)
    moe_router = w(ks[15], (N_ODD, D_MODEL, N_EXPERTS), D_MODEL)
    moe_w_gate = w(ks[16], (N_ODD, N_EXPERTS, D_MODEL, EXPERT_DIM), D_MODEL)
    moe_w_up = w(ks[17], (N_ODD, N_EXPERTS, D_MODEL, EXPERT_DIM), D_MODEL)
    moe_w_down = w(ks[18], (N_ODD, N_EXPERTS, EXPERT_DIM, D_MODEL), EXPERT_DIM)
    xa_w_q = w(ks[19], (DEPTH, D_MODEL, XA_INNER), D_MODEL)
    xa_w_out = w(ks[20], (DEPTH, XA_INNER, D_MODEL), XA_INNER)
    final_norm_gain = gain(ks[21], (D_MODEL,))
    return {'x': x, 'mem': mem, 'mem_norm_gain': mem_norm_gain, 'mem_w_kv': mem_w_kv, 'norm_gain': norm_gain, 'ret_w_in': ret_w_in, 'ret_w_out': ret_w_out, 'ret_decay_logit': ret_decay_logit, 'ret_gn_gain': ret_gn_gain, 'ffn_w_gate': ffn_w_gate, 'ffn_w_up': ffn_w_up, 'ffn_w_down': ffn_w_down, 'na_w_in': na_w_in, 'na_w_out': na_w_out, 'na_rpb': na_rpb, 'moe_router': moe_router, 'moe_w_gate': moe_w_gate, 'moe_w_up': moe_w_up, 'moe_w_down': moe_w_down, 'xa_w_q': xa_w_q, 'xa_w_out': xa_w_out, 'final_norm_gain': final_norm_gain}


def reference(x, mem, mem_norm_gain, mem_w_kv, norm_gain, ret_w_in, ret_w_out, ret_decay_logit, ret_gn_gain, ffn_w_gate, ffn_w_up, ffn_w_down, na_w_in, na_w_out, na_rpb, moe_router, moe_w_gate, moe_w_up, moe_w_down, xa_w_q, xa_w_out, final_norm_gain):
    b, m, _ = mem.shape
    mem_kv = _rms_norm(mem, mem_norm_gain) @ mem_w_kv
    mem_k = mem_kv[..., :XA_INNER].reshape(b, m, XA_HEADS, XA_HEAD_DIM)
    mem_v = mem_kv[..., XA_INNER:].reshape(b, m, XA_HEADS, XA_HEAD_DIM)
    h = x
    for i in range(DEPTH):
        j = i // 2
        hn = _rms_norm(h, norm_gain[i, 0])
        if i % N_MIXERS == 0:
            h = h + _retention_mixer(hn, ret_w_in[j], ret_w_out[j], ret_decay_logit[j], ret_gn_gain[j])
        else:
            h = h + _neighbourhood_attention(hn, na_w_in[j], na_w_out[j], na_rpb[j])
        h = h + _memory_cross_attention(_rms_norm(h, norm_gain[i, 1]), mem_k, mem_v, xa_w_q[i], xa_w_out[i])
        hn = _rms_norm(h, norm_gain[i, 2])
        if i % 2 == 0:
            h = h + _swiglu(hn, ffn_w_gate[j], ffn_w_up[j], ffn_w_down[j])
        else:
            h = h + _moe_swiglu(hn, moe_router[j], moe_w_gate[j], moe_w_up[j], moe_w_down[j])
    return _rms_norm(h, final_norm_gain)
```

```cpp
#include <hip/hip_runtime.h>
#include <cstdio>
#include <cstdint>

#ifndef ONLY
#define ONLY -1
#endif
#ifndef PLO
#define PLO 0
#endif
#ifndef PHI
#define PHI 99
#endif
#define PH(n) ((ONLY < 0 || ONLY == (n)) && (n) >= PLO && (n) <= PHI)
#ifndef DBLMASK
#define DBLMASK 0u
#endif
#define NREP(k) ((((unsigned)(DBLMASK)) >> (k)) & 1u ? 2 : 1)
#if DBLMASK
#define REPLOOP(k) for (int rep_ = 0; rep_ < NREP(k); ++rep_)
#else
#define REPLOOP(k)
#endif
#ifndef SUB
#define SUB -1
#endif
#define SB(j) (SUB < 0 || SUB == (j))
#define LAS __attribute__((address_space(3)))
typedef unsigned short bf16_t;
typedef short bf16x8 __attribute__((ext_vector_type(8)));
typedef float f32x4 __attribute__((ext_vector_type(4)));
typedef float f32x2 __attribute__((ext_vector_type(2)));
typedef unsigned u32x4 __attribute__((ext_vector_type(4)));
typedef unsigned u32x2 __attribute__((ext_vector_type(2)));

constexpr int T = 16384, D = 2048, NMEM = 256;
constexpr int RH = 8, RDK = 256, RDV = 512, RC = 256, RNC = T / RC;
constexpr int FFN = 5632, NE = 8, EDIM = 7168;
constexpr int NAH = 16;
constexpr int MOE_ROWS_MAX = 34816;
constexpr float RMS_EPS = 1e-6f, GN_EPS = 1e-6f;

constexpr size_t MiB = 1u << 20;
constexpr size_t WS_CTL = 0, CTL_ZERO_BYTES = 196608;
constexpr size_t CTL_CMAX_FFN = 65536, CTL_CMAX_NA = 65536 + 45056, CTL_CMAX_RET = 65536 + 45056 + 24576, CTL_CMAX_QK = 65536 + 45056 + 24576 + 49152;
constexpr size_t WS_W_RETIN = 1 * MiB, WS_W_RETOUT = 49 * MiB, WS_W_FFNGU = 65 * MiB, WS_W_FFND = 109 * MiB, WS_W_NAIN = 131 * MiB, WS_W_NAOUT = 155 * MiB;
constexpr size_t WS_W_XQ = 163 * MiB, WS_W_XOT = 167 * MiB, WS_W_MEMKV = 171 * MiB, WS_W_QK = 175 * MiB, WS_W_VO = 183 * MiB;
constexpr size_t WS_MEMK = 191 * MiB, WS_MEMV = 192 * MiB, WS_MEMN = 193 * MiB, WS_LIST = 194 * MiB, WS_TOKINFO = 194 * MiB + 512 * 1024;
constexpr size_t WS_RS = 194 * MiB + 768 * 1024;
constexpr size_t WS_HN = 196 * MiB;
constexpr size_t WS_BS = 260 * MiB, WS_AP = 644 * MiB;
constexpr size_t WS_X = 836 * MiB;
constexpr size_t WS_W_MOEGU = 1380 * MiB, WS_W_MOED = 1604 * MiB;
constexpr size_t WS_HN8 = WS_X + 376 * MiB;
constexpr size_t WS_QB = WS_X, WS_KB = WS_X + 64 * MiB, WS_KZ = WS_X + 128 * MiB, WS_GB = WS_X + 256 * MiB, WS_YRAW = WS_X + 384 * MiB;
constexpr size_t WS_XP = WS_X + 512 * MiB;
constexpr size_t WS_FHID = WS_X;
constexpr size_t WS_NQ = WS_X, WS_NK = WS_X + 64 * MiB, WS_NVT = WS_X + 128 * MiB, WS_NATT = WS_X + 192 * MiB;
constexpr size_t WS_XG = WS_X, WS_MHID = WS_X + 136 * MiB;
constexpr size_t WS_H16 = WS_BS;
constexpr size_t WS_YP = 1716 * MiB;
constexpr size_t WS_END = 1748 * MiB;
constexpr int CW_BAR = 4096, CW_CNT = 8192;

constexpr int RING_BYTES = 131072, EXCH_OFF = RING_BYTES, EXCH_BYTES = 8192, MISC_OFF = EXCH_OFF + EXCH_BYTES, LDS_BYTES = 147456;

__device__ __forceinline__ unsigned cvt_pk_bf16(float lo, float hi) { unsigned r; asm volatile("v_cvt_pk_bf16_f32 %0, %1, %2" : "=v"(r) : "v"(lo), "v"(hi)); return r; }
__device__ __forceinline__ float bf_lo(unsigned w) { return __uint_as_float(w << 16); }
__device__ __forceinline__ float bf_hi(unsigned w) { return __uint_as_float(w & 0xffff0000u); }
__device__ __forceinline__ float wave_sum(float v) {
#pragma unroll
    for (int o = 1; o < 64; o <<= 1) v += __shfl_xor(v, o);
    return v;
}
__device__ __forceinline__ float fast_exp(float x) { return __builtin_amdgcn_exp2f(x * 1.44269504f); }
__device__ __forceinline__ float silu_f(float x) { return x * __builtin_amdgcn_rcpf(1.0f + fast_exp(-x)); }
__device__ __forceinline__ float log2_decay(const float* decay_logit, int dir, int h) {
    const float z = decay_logit[dir * RH + h];
    return -log1pf(expf(-z)) * 1.44269504f;
}
__device__ __forceinline__ int tid_now(int wave) { unsigned z; asm volatile("v_mov_b32 %0, 0" : "=v"(z)); return wave * 64 + (int)__builtin_amdgcn_mbcnt_hi(~0u, __builtin_amdgcn_mbcnt_lo(~0u, z)); }
#define LDS_WAIT() asm volatile("s_waitcnt lgkmcnt(0)" ::: "memory")
#define VM_WAIT() asm volatile("s_waitcnt vmcnt(0)" ::: "memory")

#define XB_TMO      128
#define XB_XCNT(j)  (256  + 64 * (j))
#define XB_XSUB(j)  (1280 + 64 * (j))
#define XB_XGEN(j)  (2304 + 64 * (j))
#define XB_TOP      3328
#define XB_TOPGEN   3392
#define XCD_BAR_WORDS 3456
#define XB_SPIN_CAP (1u << 18)

__device__ __forceinline__ unsigned xb_ld(unsigned* p)              { return __hip_atomic_load(p, __ATOMIC_RELAXED, __HIP_MEMORY_SCOPE_AGENT); }
__device__ __forceinline__ unsigned xb_add(unsigned* p, unsigned v) { return __hip_atomic_fetch_add(p, v, __ATOMIC_RELAXED, __HIP_MEMORY_SCOPE_AGENT); }
__device__ __forceinline__ unsigned xb_xcc_id() { return (unsigned)__builtin_amdgcn_s_getreg((3 << 11) | 20) & 0xFu; }
#define XB_SPIN(cond, bar) do { unsigned _sp = 0; while (cond) { __builtin_amdgcn_s_sleep(1); \
    if ((++_sp & 255u) == 0u) { if (xb_ld(&(bar)[XB_TMO])) break; if (_sp > XB_SPIN_CAP) { atomicAdd(&(bar)[XB_TMO], 1u); break; } } } } while (0)

struct XcdBarrier { unsigned* bar; unsigned x; volatile LAS unsigned* st; };

__device__ __forceinline__ XcdBarrier xcd_barrier_post(unsigned* bar, volatile LAS unsigned* st) {
    XcdBarrier b; b.bar = bar; b.x = xb_xcc_id(); b.st = st;
    if (threadIdx.x == 0) (void)xb_add(&bar[XB_XCNT(b.x)], 1u);
    return b;
}
__device__ __forceinline__ void xcd_barrier_complete(unsigned* bar, unsigned x, unsigned& nloc, unsigned& nx) {
    const unsigned G = gridDim.x * gridDim.y * gridDim.z;
    unsigned sum, cnt, mine, sp = 0u;
    for (;;) {
        sum = 0u; cnt = 0u; mine = 0u;
#pragma unroll
        for (unsigned j = 0; j < 16; ++j) { const unsigned c = xb_ld(&bar[XB_XCNT(j)]); sum += c; cnt += (c > 0u) ? 1u : 0u; mine = (j == x) ? c : mine; }
        if (sum == G) break;
        __builtin_amdgcn_s_sleep(1);
        if ((++sp & 255u) == 0u) { if (xb_ld(&bar[XB_TMO])) break; if (sp > XB_SPIN_CAP) { atomicAdd(&bar[XB_TMO], 1u); break; } }
    }
    nloc = mine > 0u ? mine : 1u; nx = cnt > 0u ? cnt : 1u;
}
__device__ __forceinline__ void xcd_barrier(const XcdBarrier& b, const bool t0  ) {
    asm volatile("s_waitcnt vmcnt(0)" ::: "memory");
    __syncthreads();
    if (t0) {
        unsigned* bar = b.bar; asm volatile("" : "+s"(bar));
        __builtin_amdgcn_s_waitcnt(0);
        unsigned nloc = b.st[0], nx = b.st[1];
        if (nloc == 0u) { xcd_barrier_complete(bar, b.x, nloc, nx); b.st[0] = nloc; b.st[1] = nx; }
        const unsigned old = xb_add(&bar[XB_XSUB(b.x)], 1u);
        const unsigned gen = old / nloc;
        if (old + 1u == (gen + 1u) * nloc) {
            __builtin_amdgcn_fence(__ATOMIC_RELEASE, "agent");
            asm volatile("s_waitcnt vmcnt(0)" ::: "memory");
            const unsigned og = xb_add(&bar[XB_TOP], 1u);
            const unsigned tg = og / nx;
            if (og + 1u == (tg + 1u) * nx) xb_add(&bar[XB_TOPGEN], 1u);
            else XB_SPIN(xb_ld(&bar[XB_TOPGEN]) == tg, bar);
            __builtin_amdgcn_fence(__ATOMIC_ACQUIRE, "agent");
            xb_add(&bar[XB_XGEN(b.x)], 1u);
            asm volatile("s_waitcnt vmcnt(0)" ::: "memory");
        } else {
            XB_SPIN(xb_ld(&bar[XB_XGEN(b.x)]) == gen, bar);
            __builtin_amdgcn_fence(__ATOMIC_ACQUIRE, "agent");
            asm volatile("s_waitcnt vmcnt(0)" ::: "memory");
        }
    }
    __syncthreads();
}

__device__ __forceinline__ const char* uni_ptr(const char* p) { const unsigned long long v = (unsigned long long)p; const unsigned lo = __builtin_amdgcn_readfirstlane((int)(unsigned)v), hi = __builtin_amdgcn_readfirstlane((int)(unsigned)(v >> 32));
    return (const char*)(((unsigned long long)hi << 32) | lo); }
typedef int v8i32 __attribute__((ext_vector_type(8)));
typedef int v4i32 __attribute__((ext_vector_type(4)));
__device__ __forceinline__ v8i32 pk8(bf16x8 lo, bf16x8 hi) { return __builtin_shufflevector(__builtin_bit_cast(v4i32, lo), __builtin_bit_cast(v4i32, hi), 0, 1, 2, 3, 4, 5, 6, 7); }
__device__ __forceinline__ unsigned pk4_fp8(float a, float b, float c, float d) { int r = __builtin_amdgcn_cvt_pk_fp8_f32(a, b, 0, false); r = __builtin_amdgcn_cvt_pk_fp8_f32(c, d, r, true); return (unsigned)r; }
__device__ __forceinline__ unsigned pk4_i8(f32x4 v, float inv) {
    const int a = (int)__builtin_rintf(v[0] * inv), b = (int)__builtin_rintf(v[1] * inv), c = (int)__builtin_rintf(v[2] * inv), d = (int)__builtin_rintf(v[3] * inv);
    return ((unsigned)a & 0xffu) | (((unsigned)b & 0xffu) << 8) | (((unsigned)c & 0xffu) << 16) | ((unsigned)d << 24); }
typedef _Float16 f16x4 __attribute__((ext_vector_type(4)));
typedef unsigned short h16_t;
__device__ __forceinline__ f32x4 h4_to_f32(u32x2 w) { return __builtin_convertvector(__builtin_bit_cast(f16x4, w), f32x4); }
__device__ __forceinline__ u32x2 f32_to_h4(f32x4 v) { return __builtin_bit_cast(u32x2, __builtin_convertvector(v, f16x4)); }
__device__ __forceinline__ float wave_max(float v) {
#pragma unroll
    for (int o = 1; o < 64; o <<= 1) v = fmaxf(v, __shfl_xor(v, o));
    return v;
}
namespace pg8 {
constexpr int BM = 256, BK = 64, HALF = 128, HTB = HALF * BK * 2, STAGE_BYTES = 8 * HTB, NXCD = 8, WGM = 4;
__host__ __device__ __forceinline__ int lds_byte(int r, int c) { const int st = (r >> 4) * 2 + (c >> 5), rr = r & 15, cc = c & 31, ob = rr * 64 + cc * 2; return st * 1024 + (ob ^ (((ob >> 9) & 1) << 5)); }
__host__ __device__ __forceinline__ void stage_rc(int b, int& R, int& C) { const int st = b / 1024, sb = b % 1024, swz = sb ^ (((sb >> 9) & 1) << 5); R = (st >> 1) * 16 + swz / 64; C = (st & 1) * 32 + (swz % 64) / 2; }
__host__ __device__ __forceinline__ int perm32(int rho) { const int n = rho >> 4, i = rho & 15; return 8 * (i >> 2) + 4 * n + (i & 3); }

struct Unit { int pm, pn, kq; };
struct Order {
    int nM, nN, nwg, G, c, i0, i1;
    __device__ __forceinline__ void init(int nM_, int nN_, int G_, int c_) { nM = nM_; nN = nN_; nwg = nM * nN; G = G_; c = c_; i0 = 0; i1 = 0x7fffffff; }
    __device__ __forceinline__ bool next(int i, Unit& u) const {
        const int ii = i + i0; if (ii >= i1) return false;
        const long L = (long)ii * G + c; if (L >= nwg) return false;
        int wgid = (int)L; { const int q = nwg / NXCD, r = nwg % NXCD, xcd = wgid % NXCD, off = wgid / NXCD; wgid = (xcd < r ? xcd * (q + 1) : r * (q + 1) + (xcd - r) * q) + off; }
        const int nig = WGM * nN, gid = wgid / nig, fm = gid * WGM, gsz = (nM - fm) < WGM ? (nM - fm) : WGM;
        u.pm = fm + ((wgid % nig) % gsz); u.pn = (wgid % nig) / gsz; u.kq = -1; return true;
    }
    __device__ __forceinline__ int unit_nt(const Unit&, int nt) const { return nt; }
};

struct OrderPair {
    int nM, G, c;
    __device__ __forceinline__ void init(int nM_, int G_, int c_) { nM = nM_; G = G_; c = c_; }
    __device__ __forceinline__ bool next(int i, Unit& u) const { const int pm = (i >> 1) * G + c; if (pm >= nM) return false; u.pm = pm; u.pn = i & 1; u.kq = -1; return true; }
    __device__ __forceinline__ int unit_nt(const Unit&, int nt) const { return nt; }
};
struct OrderTail {
    int nwg, G, c, R, L; bool split;
    __device__ __forceinline__ void init(int nM, int G_, int c_) { nwg = nM * 8; G = G_; const int r = nwg / G_, l = nwg % G_; split = ((G_ & 7) == 0) && l > 0 && l <= 64; R = split ? r : (nwg + G_ - 1) / G_; L = split ? l : 0;
        c = ((G_ & 7) == 0) ? (c_ & 7) * (G_ >> 3) + (c_ >> 3) : c_; }
    __device__ __forceinline__ int tail_tile0() const { return split ? R * G : 0x7fffffff; }
    __device__ __forceinline__ bool next(int i, Unit& u) const {
        if (i < R) { const int idx = i * G + c; if (idx >= nwg) return false; u.pm = idx >> 3; u.pn = idx & 7; u.kq = -1; return true; }
        const int v = (i - R) * G + c; if (v >= 4 * L) return false;
        const int idx = R * G + (v >> 2); u.pm = idx >> 3; u.pn = idx & 7; u.kq = v & 3; return true;
    }
    __device__ __forceinline__ int unit_nt(const Unit& u, int nt) const { return u.kq < 0 ? nt : (nt >> 2); }
};

#ifndef ALIGN_ALL
#define ALIGN_ALL 1
#endif
template <int FMT = 2  , bool ALIGN = (ALIGN_ALL != 0), class Epi, class Map, class Sched>
__device__ __forceinline__ void gemm_phase(LAS unsigned char* lds, const int wave_, const Sched& S, const Map& MP, const int K, const int lda, const int ldb, const Epi& E) {
    int tid_ = tid_now(wave_); asm volatile("" : "+v"(tid_));
    const int tid = tid_, wid = __builtin_amdgcn_readfirstlane(tid >> 6), lane = tid & 63, wr = wid >> 2, wc = wid & 3, fr = lane & 15, fq = lane >> 4;
    constexpr int ESZ = (FMT == 2) ? 2 : 1;
    int nt = K * ESZ / (BK * 2);
    asm volatile("" : "+s"(nt));
    unsigned voffA[2], voffB[2];
#pragma unroll
    for (int i = 0; i < 2; ++i) { int R, C; stage_rc(tid * 16 + i * 8192, R, C); const int Rb = Epi::PERM ? ((R & ~31) + perm32(R & 31)) : R;
        voffA[i] = (unsigned)(R * lda * ESZ + C * 2); voffB[i] = (unsigned)(Rb * ldb * ESZ + C * 2); }
    const size_t kstep = (size_t)(BK * 2);
    const size_t hstepA = (size_t)HALF * lda * ESZ, hstepB = (size_t)HALF * ldb * ESZ;
    const unsigned ldsw = (unsigned)wid * 1024u;
    const unsigned ldsbase = (unsigned)__builtin_amdgcn_readfirstlane((int)(unsigned)(size_t)lds + (int)ldsw);
    const int aoff = lds_byte(wr * 64 + fr, fq * 8), boff = lds_byte(wc * 32 + fr, fq * 8);
#define PG8_SA(b, h) (((b) * 2 + (h)) * HTB)
#define PG8_SB(b, h) ((4 + (b) * 2 + (h)) * HTB)
#define PG8_STAGE(bufoff, gbase, voff) do { _Pragma("unroll") for (int _i = 0; _i < 2; ++_i) { unsigned keep_; \
        asm volatile("s_mov_b32 %0, m0\n\ts_add_u32 m0, %3, %4\n\ts_nop 0\n\tglobal_load_lds_dwordx4 %1, %2\n\ts_mov_b32 m0, %0" \
            : "=&s"(keep_) : "v"((voff)[_i]), "s"((const char*)(gbase)), "s"(ldsbase), "n"((bufoff) + _i * 8192) : "memory", "scc"); } } while (0)
#define PG8_LDA(dst, b, h) do { _Pragma("unroll") for (int m = 0; m < 4; ++m) { _Pragma("unroll") for (int k = 0; k < 2; ++k) dst[m][k] = *(const LAS bf16x8*)(lds + PG8_SA(b, h) + aoff + m * 2048 + k * 1024); \
        if constexpr (FMT == 1) dst##8[m] = pk8(dst[m][0], dst[m][1]); } } while (0)
#define PG8_LDB(dst, b, h) do { _Pragma("unroll") for (int n = 0; n < 2; ++n) { _Pragma("unroll") for (int k = 0; k < 2; ++k) dst[n][k] = *(const LAS bf16x8*)(lds + PG8_SB(b, h) + boff + n * 2048 + k * 1024); \
        if constexpr (FMT == 1) dst##8[n] = pk8(dst[n][0], dst[n][1]); } } while (0)
#define PG8_MMA(ai, bj, At, Bt) do { __builtin_amdgcn_s_setprio(1); _Pragma("unroll") for (int m = 0; m < 4; ++m) _Pragma("unroll") for (int n = 0; n < 2; ++n) { \
        if constexpr (FMT == 2) { _Pragma("unroll") for (int k = 0; k < 2; ++k) acc[ai][bj][m][n] = __builtin_amdgcn_mfma_f32_16x16x32_bf16(Bt[n][k], At[m][k], acc[ai][bj][m][n], 0, 0, 0); } \
        else if constexpr (FMT == 3) { _Pragma("unroll") for (int k = 0; k < 2; ++k) acc[ai][bj][m][n] = __builtin_bit_cast(f32x4, __builtin_amdgcn_mfma_i32_16x16x64_i8(__builtin_bit_cast(v4i32, Bt[n][k]), __builtin_bit_cast(v4i32, At[m][k]), __builtin_bit_cast(v4i32, acc[ai][bj][m][n]), 0, 0, 0)); } \
        else { acc[ai][bj][m][n] = __builtin_amdgcn_mfma_scale_f32_16x16x128_f8f6f4(Bt##8[n], At##8[m], acc[ai][bj][m][n], 0, 0, 0, 0x7f7f7f7f, 0, 0x7f7f7f7f); } } \
        __builtin_amdgcn_s_setprio(0); } while (0)
#define PG8_WAIT_V(n) asm volatile("s_waitcnt vmcnt(" #n ")" ::: "memory")
#define PG8_WAIT_L(n) asm volatile("s_waitcnt lgkmcnt(" #n ")" ::: "memory")
#define PG8_BAR __builtin_amdgcn_s_barrier()
#define PG8_SCHED __builtin_amdgcn_sched_barrier(0)
    Unit cur, nxt; int ui = 0;
    if (!S.next(0, cur)) return;
    f32x4 acc[2][2][4][2];
#pragma unroll
    for (int a = 0; a < 2; ++a)
#pragma unroll
        for (int b = 0; b < 2; ++b)
#pragma unroll
            for (int m = 0; m < 4; ++m)
#pragma unroll
                for (int n = 0; n < 2; ++n) acc[a][b][m][n] = (f32x4){0.f, 0.f, 0.f, 0.f};
    bf16x8 At[4][2], B0[2][2], B1[2][2]; v8i32 At8[4], B08[2], B18[2];
    const char* cA; const char* cB; MP(cur, cA, cB); cA = uni_ptr(cA); cB = uni_ptr(cB);
    PG8_STAGE(PG8_SB(0, 0), cB, voffB); PG8_STAGE(PG8_SB(0, 1), cB + hstepB, voffB); PG8_STAGE(PG8_SA(0, 0), cA, voffA); PG8_STAGE(PG8_SA(0, 1), cA + hstepA, voffA);
    if (wr == 1) PG8_BAR;
    PG8_WAIT_V(2); PG8_BAR;
    PG8_STAGE(PG8_SB(1, 0), cB + kstep, voffB); PG8_STAGE(PG8_SA(1, 0), cA + kstep, voffA); PG8_STAGE(PG8_SB(1, 1), cB + hstepB + kstep, voffB);
    PG8_WAIT_V(6); PG8_BAR;
    for (;;) {
        const bool has_next = S.next(ui + 1, nxt);
        const char* nA = cA; const char* nB = cB; if (has_next) { MP(nxt, nA, nB); nA = uni_ptr(nA); nB = uni_ptr(nB); }
        const int unt = S.unit_nt(cur, nt);
#pragma unroll 1
        for (int t = 0; t < unt; t += 2) {
            const bool last = (t == unt - 2);
            const char* a1 = cA + (size_t)(t + 1) * kstep;
            const char* a2 = last ? nA : cA + (size_t)(t + 2) * kstep; const char* b2 = last ? nB : cB + (size_t)(t + 2) * kstep;
            const char* a3 = a2 + kstep; const char* b3 = b2 + kstep;
            PG8_LDB(B0, 0, 0); PG8_LDB(B1, 0, 1); PG8_SCHED; PG8_LDA(At, 0, 0); PG8_STAGE(PG8_SA(1, 1), a1 + hstepA, voffA);
            PG8_WAIT_V(8); PG8_WAIT_L(0); PG8_BAR; PG8_MMA(0, 0, At, B0); PG8_MMA(0, 1, At, B1); PG8_BAR; PG8_SCHED;
            PG8_LDA(At, 0, 1); PG8_STAGE(PG8_SB(0, 0), b2, voffB); PG8_STAGE(PG8_SB(0, 1), b2 + hstepB, voffB); PG8_STAGE(PG8_SA(0, 0), a2, voffA);
            PG8_WAIT_V(8); PG8_WAIT_L(0); PG8_BAR; PG8_MMA(1, 0, At, B0); PG8_MMA(1, 1, At, B1); PG8_BAR; PG8_SCHED;
            PG8_LDB(B0, 1, 0); PG8_LDB(B1, 1, 1); PG8_SCHED; PG8_LDA(At, 1, 0); PG8_STAGE(PG8_SA(0, 1), a2 + hstepA, voffA);
            PG8_WAIT_V(8); PG8_WAIT_L(0); PG8_BAR; PG8_MMA(0, 0, At, B0); PG8_MMA(0, 1, At, B1); PG8_BAR; PG8_SCHED;
            PG8_LDA(At, 1, 1); PG8_STAGE(PG8_SB(1, 0), b3, voffB); PG8_STAGE(PG8_SB(1, 1), b3 + hstepB, voffB); PG8_STAGE(PG8_SA(1, 0), a3, voffA);
            PG8_WAIT_V(8); PG8_WAIT_L(0); PG8_BAR; PG8_MMA(1, 0, At, B0); PG8_MMA(1, 1, At, B1); PG8_BAR; PG8_SCHED;
        }
        if constexpr (ALIGN) { if (wr == 0) PG8_BAR; }
        E(acc, cur, wr, wc, fr, fq);
        if (!has_next) break;
#pragma unroll
        for (int a = 0; a < 2; ++a)
#pragma unroll
            for (int b = 0; b < 2; ++b)
#pragma unroll
                for (int m = 0; m < 4; ++m)
#pragma unroll
                    for (int n = 0; n < 2; ++n) acc[a][b][m][n] = (f32x4){0.f, 0.f, 0.f, 0.f};
        cur = nxt; cA = nA; cB = nB; ++ui;
        if constexpr (ALIGN) { if (wr == 1) PG8_BAR; }
    }
    PG8_WAIT_V(0);
    if constexpr (!ALIGN) { if (wr == 0) PG8_BAR; }
    PG8_BAR;
#undef PG8_SA
#undef PG8_SB
#undef PG8_STAGE
#undef PG8_LDA
#undef PG8_LDB
#undef PG8_MMA
#undef PG8_WAIT_V
#undef PG8_WAIT_L
#undef PG8_BAR
#undef PG8_SCHED
}
}
using pg8::Unit;

template <class Addr> struct EpiStore {
    static constexpr bool PERM = true;
    Addr ad;
    __device__ __forceinline__ void operator()(const f32x4 (&acc)[2][2][4][2], const Unit& u, int wr, int wc, int fr, int fq) const {
        asm volatile("" : "+v"(fr), "+v"(fq));
        int ldc; float sc; bf16_t* base = ad(u, ldc, sc);
        const int row0 = wr * 64 + fr, col0 = wc * 32 + 8 * fq;
#pragma unroll
        for (int ai = 0; ai < 2; ++ai)
#pragma unroll
            for (int m = 0; m < 4; ++m) { bf16_t* rowp = base + (size_t)(row0 + ai * 128 + m * 16) * ldc + col0;
#pragma unroll
                for (int bj = 0; bj < 2; ++bj) { const f32x4 v0 = acc[ai][bj][m][0] * sc, v1 = acc[ai][bj][m][1] * sc;
                    u32x4 w; w.x = cvt_pk_bf16(v0[0], v0[1]); w.y = cvt_pk_bf16(v0[2], v0[3]); w.z = cvt_pk_bf16(v1[0], v1[1]); w.w = cvt_pk_bf16(v1[2], v1[3]);
                    *(u32x4*)(rowp + bj * 128) = w; } }
    }
};
struct EpiRetYGN {
    static constexpr bool PERM = true;
    bf16_t* YRAW; bf16_t* GB; const float* gn_gain; LAS unsigned char* ex; LAS unsigned char* tot;
    __device__ __forceinline__ void operator()(const f32x4 (&acc)[2][2][4][2], const Unit& u, int wr, int wc, int fr, int fq) const {
        asm volatile("" : "+v"(fr), "+v"(fq));
        const int h = u.pm >> 6, ci = u.pm & 63, t = u.pn;
        const int row0 = wr * 64 + fr, col0 = wc * 32 + 8 * fq;
        LAS f32x2* X = (LAS f32x2*)ex; LAS f32x2* TT = (LAS f32x2*)tot;
#pragma unroll
        for (int ai = 0; ai < 2; ++ai)
#pragma unroll
            for (int m = 0; m < 4; ++m) { float s = 0.f, q = 0.f;
#pragma unroll
                for (int bj = 0; bj < 2; ++bj)
#pragma unroll
                    for (int n = 0; n < 2; ++n)
#pragma unroll
                        for (int e = 0; e < 4; ++e) { const float v = acc[ai][bj][m][n][e]; s += v; q += v * v; }
                s += __shfl_xor(s, 16); s += __shfl_xor(s, 32); q += __shfl_xor(q, 16); q += __shfl_xor(q, 32);
                if (fq == 0) X[(row0 + ai * 128 + m * 16) * 4 + wc] = (f32x2){s, q}; }
        LDS_WAIT(); __builtin_amdgcn_s_barrier(); asm volatile("" ::: "memory");
        const size_t tok0 = (size_t)ci * 256;
        if (t == 0) {
#pragma unroll
            for (int ai = 0; ai < 2; ++ai)
#pragma unroll
                for (int m = 0; m < 4; ++m) { const int r = row0 + ai * 128 + m * 16;
                    if (wc == 0 && fq == 0) { const f32x2 a = X[r * 4 + 0], b = X[r * 4 + 1], c = X[r * 4 + 2], d = X[r * 4 + 3]; TT[r] = (f32x2){(a.x + b.x) + (c.x + d.x), (a.y + b.y) + (c.y + d.y)}; }
                    bf16_t* rowp = YRAW + (tok0 + r) * 4096 + h * 512 + col0;
#pragma unroll
                    for (int bj = 0; bj < 2; ++bj) { const f32x4 v0 = acc[ai][bj][m][0], v1 = acc[ai][bj][m][1];
                        u32x4 w; w.x = cvt_pk_bf16(v0[0], v0[1]); w.y = cvt_pk_bf16(v0[2], v0[3]); w.z = cvt_pk_bf16(v1[0], v1[1]); w.w = cvt_pk_bf16(v1[2], v1[3]);
                        *(u32x4*)(rowp + bj * 128) = w; } }
        } else {
            f32x4 gn0[2][2], gn1[2][2];
#pragma unroll
            for (int bj = 0; bj < 2; ++bj) { const float* g = gn_gain + h * 512 + bj * 128 + col0;
                gn0[bj][0] = *(const f32x4*)g; gn0[bj][1] = *(const f32x4*)(g + 4); gn1[bj][0] = *(const f32x4*)(g + 256); gn1[bj][1] = *(const f32x4*)(g + 260); }
#pragma unroll
            for (int ai = 0; ai < 2; ++ai)
#pragma unroll
                for (int m = 0; m < 4; ++m) { const int r = row0 + ai * 128 + m * 16;
                    const f32x2 a = X[r * 4 + 0], b = X[r * 4 + 1], c = X[r * 4 + 2], d = X[r * 4 + 3], z = TT[r];
                    const float S = ((a.x + b.x) + (c.x + d.x)) + z.x, Q = ((a.y + b.y) + (c.y + d.y)) + z.y;
                    const float mu = S * (1.0f / 512.0f); const float var = fmaxf(Q * (1.0f / 512.0f) - mu * mu, 0.f); const float rstd = 1.0f / sqrtf(var + GN_EPS);
                    const size_t ro = (tok0 + r) * 4096 + h * 512 + col0;
#pragma unroll
                    for (int bj = 0; bj < 2; ++bj) {
                        { const u32x4 gv = *(const u32x4*)(GB + ro + 256 + bj * 128);
                          const f32x4 g0 = (f32x4){bf_lo(gv.x), bf_hi(gv.x), bf_lo(gv.y), bf_hi(gv.y)}, g1 = (f32x4){bf_lo(gv.z), bf_hi(gv.z), bf_lo(gv.w), bf_hi(gv.w)};
                          const f32x4 o0 = (acc[ai][bj][m][0] - mu) * rstd * gn1[bj][0] * g0, o1 = (acc[ai][bj][m][1] - mu) * rstd * gn1[bj][1] * g1;
                          u32x4 w; w.x = cvt_pk_bf16(o0[0], o0[1]); w.y = cvt_pk_bf16(o0[2], o0[3]); w.z = cvt_pk_bf16(o1[0], o1[1]); w.w = cvt_pk_bf16(o1[2], o1[3]);
                          *(u32x4*)(GB + ro + 256 + bj * 128) = w; }
                        { const u32x4 yv = *(const u32x4*)(YRAW + ro + bj * 128); const u32x4 gv = *(const u32x4*)(GB + ro + bj * 128);
                          const f32x4 y0 = (f32x4){bf_lo(yv.x), bf_hi(yv.x), bf_lo(yv.y), bf_hi(yv.y)}, y1 = (f32x4){bf_lo(yv.z), bf_hi(yv.z), bf_lo(yv.w), bf_hi(yv.w)};
                          const f32x4 g0 = (f32x4){bf_lo(gv.x), bf_hi(gv.x), bf_lo(gv.y), bf_hi(gv.y)}, g1 = (f32x4){bf_lo(gv.z), bf_hi(gv.z), bf_lo(gv.w), bf_hi(gv.w)};
                          const f32x4 o0 = (y0 - mu) * rstd * gn0[bj][0] * g0, o1 = (y1 - mu) * rstd * gn0[bj][1] * g1;
                          u32x4 w; w.x = cvt_pk_bf16(o0[0], o0[1]); w.y = cvt_pk_bf16(o0[2], o0[3]); w.z = cvt_pk_bf16(o1[0], o1[1]); w.w = cvt_pk_bf16(o1[2], o1[3]);
                          *(u32x4*)(GB + ro + bj * 128) = w; } } }
        }
        LDS_WAIT(); __builtin_amdgcn_s_barrier(); asm volatile("" ::: "memory");
    }
};
template <class Addr> struct EpiSilu {
    static constexpr bool PERM = true;
    Addr ad;
    __device__ __forceinline__ void operator()(const f32x4 (&acc)[2][2][4][2], const Unit& u, int wr, int wc, int fr, int fq) const {
        asm volatile("" : "+v"(fr), "+v"(fq));
        int ldc; float sc; bf16_t* base = ad(u, ldc, sc);
        const int row0 = wr * 64 + fr, col0 = wc * 32 + 8 * fq;
#pragma unroll
        for (int ai = 0; ai < 2; ++ai)
#pragma unroll
            for (int m = 0; m < 4; ++m) { bf16_t* rowp = base + (size_t)(row0 + ai * 128 + m * 16) * ldc + col0;
#pragma unroll
                for (int bj = 0; bj < 2; ++bj) { f32x4 v0 = acc[ai][bj][m][0], v1 = acc[ai][bj][m][1];
#pragma unroll
                    for (int e = 0; e < 4; ++e) { v0[e] = silu_f(v0[e]); v1[e] = silu_f(v1[e]); }
                    u32x4 w; w.x = cvt_pk_bf16(v0[0], v0[1]); w.y = cvt_pk_bf16(v0[2], v0[3]); w.z = cvt_pk_bf16(v1[0], v1[1]); w.w = cvt_pk_bf16(v1[2], v1[3]);
                    *(u32x4*)(rowp + bj * 128) = w; } }
    }
};
template <class Addr> struct EpiSwiglu {
    static constexpr bool PERM = true;
    Addr ad;
    __device__ __forceinline__ void operator()(const f32x4 (&acc)[2][2][4][2], const Unit& u, int wr, int wc, int fr, int fq) const {
        asm volatile("" : "+v"(fr), "+v"(fq));
        int ldc; float sc; bf16_t* base = ad(u, ldc, sc);
        const int row0 = wr * 64 + fr, col0 = wc * 32 + 8 * fq;
#pragma unroll
        for (int ai = 0; ai < 2; ++ai)
#pragma unroll
            for (int m = 0; m < 4; ++m) { bf16_t* rowp = base + (size_t)(row0 + ai * 128 + m * 16) * ldc + col0;
                f32x4 v0, v1;
#pragma unroll
                for (int e = 0; e < 4; ++e) { v0[e] = silu_f(acc[ai][0][m][0][e]) * acc[ai][1][m][0][e]; v1[e] = silu_f(acc[ai][0][m][1][e]) * acc[ai][1][m][1][e]; }
                u32x4 w; w.x = cvt_pk_bf16(v0[0], v0[1]); w.y = cvt_pk_bf16(v0[2], v0[3]); w.z = cvt_pk_bf16(v1[0], v1[1]); w.w = cvt_pk_bf16(v1[2], v1[3]);
                *(u32x4*)rowp = w; }
    }
};
struct EpiSwiglu8 {
    static constexpr bool PERM = true;
    unsigned char* base; int ld;
    __device__ __forceinline__ void operator()(const f32x4 (&acc)[2][2][4][2], const Unit& u, int wr, int wc, int fr, int fq) const {
        asm volatile("" : "+v"(fr), "+v"(fq));
        const int row0 = wr * 64 + fr, col0 = wc * 32 + 8 * fq;
#pragma unroll
        for (int ai = 0; ai < 2; ++ai)
#pragma unroll
            for (int m = 0; m < 4; ++m) { unsigned char* rowp = base + (size_t)(u.pm * 256 + row0 + ai * 128 + m * 16) * ld + (size_t)u.pn * 128 + col0;
                f32x4 v0, v1;
#pragma unroll
                for (int e = 0; e < 4; ++e) { v0[e] = silu_f(acc[ai][0][m][0][e] * 0.015625f) * (acc[ai][1][m][0][e] * 0.015625f); v1[e] = silu_f(acc[ai][0][m][1][e] * 0.015625f) * (acc[ai][1][m][1][e] * 0.015625f); }
                u32x2 w; w.x = pk4_fp8(v0[0], v0[1], v0[2], v0[3]); w.y = pk4_fp8(v1[0], v1[1], v1[2], v1[3]);
                *(u32x2*)rowp = w; }
    }
};
template <bool XF32>
struct EpiResidH {
    static constexpr bool PERM = true;
    const void* base; h16_t* out;
    __device__ __forceinline__ void operator()(const f32x4 (&acc)[2][2][4][2], const Unit& u, int wr, int wc, int fr, int fq) const {
        asm volatile("" : "+v"(fr), "+v"(fq));
        const int row0 = u.pm * 256 + wr * 64 + fr, col0 = u.pn * 256 + wc * 32 + 8 * fq;
#pragma unroll
        for (int ai = 0; ai < 2; ++ai)
#pragma unroll
            for (int m = 0; m < 4; ++m) { const size_t off = (size_t)(row0 + ai * 128 + m * 16) * D + col0;
#pragma unroll
                for (int bj = 0; bj < 2; ++bj) { f32x4 b0, b1;
                    if constexpr (XF32) { b0 = *(const f32x4*)((const float*)base + off + bj * 128); b1 = *(const f32x4*)((const float*)base + off + bj * 128 + 4); }
                    else { const u32x4 w = *(const u32x4*)((const h16_t*)base + off + bj * 128); b0 = h4_to_f32((u32x2){w.x, w.y}); b1 = h4_to_f32((u32x2){w.z, w.w}); }
                    const u32x2 o0 = f32_to_h4(b0 + acc[ai][bj][m][0]), o1 = f32_to_h4(b1 + acc[ai][bj][m][1]);
                    *(u32x4*)(out + off + bj * 128) = (u32x4){o0.x, o0.y, o1.x, o1.y}; } }
    }
};
struct EpiRetQK {
    static constexpr bool PERM = true;
    bf16_t* QB; bf16_t* KB; bf16_t* AP; bf16_t* KZ; const float* decay_logit;
    __device__ __forceinline__ void operator()(const f32x4 (&acc)[2][2][4][2], const Unit& u, int wr, int wc, int fr, int fq) const {
        asm volatile("" : "+v"(fr), "+v"(fq));
        const bool isq = u.pn < 8; const int h = u.pn & 7;
        const int row0 = wr * 64 + fr, col0 = wc * 32 + 8 * fq;
        float rf[2][4];
#pragma unroll
        for (int n = 0; n < 2; ++n)
#pragma unroll
            for (int e = 0; e < 4; ++e) rf[n][e] = __builtin_amdgcn_exp2f(-(float)(col0 + 4 * n + e) * (13.287712379549449f / 128.0f)) * 0.15915494309189535f;
        const float l2f = log2_decay(decay_logit, 0, h), l2b = log2_decay(decay_logit, 1, h);
#pragma unroll
        for (int ai = 0; ai < 2; ++ai)
#pragma unroll
            for (int m = 0; m < 4; ++m) {
                const int j = row0 + ai * 128 + m * 16; const int tok = u.pm * 256 + j; const float ftok = (float)tok;
                f32x4 x1[2], x2[2];
#pragma unroll
                for (int n = 0; n < 2; ++n)
#pragma unroll
                    for (int e = 0; e < 4; ++e) { const float rev = ftok * rf[n][e]; const float fr_ = rev - floorf(rev);
                        const float sn = __builtin_amdgcn_sinf(fr_), cs = __builtin_amdgcn_cosf(fr_);
                        const float a = acc[ai][0][m][n][e], b = acc[ai][1][m][n][e];
                        x1[n][e] = a * cs - b * sn; x2[n][e] = b * cs + a * sn; }
                if (isq) {
                    bf16_t* q = QB + (size_t)tok * 2048 + h * 256 + col0;
                    u32x4 w; w.x = cvt_pk_bf16(x1[0][0], x1[0][1]); w.y = cvt_pk_bf16(x1[0][2], x1[0][3]); w.z = cvt_pk_bf16(x1[1][0], x1[1][1]); w.w = cvt_pk_bf16(x1[1][2], x1[1][3]);
                    *(u32x4*)q = w;
                    w.x = cvt_pk_bf16(x2[0][0], x2[0][1]); w.y = cvt_pk_bf16(x2[0][2], x2[0][3]); w.z = cvt_pk_bf16(x2[1][0], x2[1][1]); w.w = cvt_pk_bf16(x2[1][2], x2[1][3]);
                    *(u32x4*)(q + 128) = w;
                    const float xf = __builtin_amdgcn_exp2f(l2f * (float)(j + 1)), xb = __builtin_amdgcn_exp2f(l2b * (float)(256 - j));
                    bf16_t* ap = AP + ((size_t)h * T + tok) * 768 + 256 + col0;
                    f32x4 y0 = x1[0] * xf, y1 = x1[1] * xf, z0 = x2[0] * xf, z1 = x2[1] * xf;
                    w.x = cvt_pk_bf16(y0[0], y0[1]); w.y = cvt_pk_bf16(y0[2], y0[3]); w.z = cvt_pk_bf16(y1[0], y1[1]); w.w = cvt_pk_bf16(y1[2], y1[3]); *(u32x4*)ap = w;
                    w.x = cvt_pk_bf16(z0[0], z0[1]); w.y = cvt_pk_bf16(z0[2], z0[3]); w.z = cvt_pk_bf16(z1[0], z1[1]); w.w = cvt_pk_bf16(z1[2], z1[3]); *(u32x4*)(ap + 128) = w;
                    y0 = x1[0] * xb; y1 = x1[1] * xb; z0 = x2[0] * xb; z1 = x2[1] * xb;
                    w.x = cvt_pk_bf16(y0[0], y0[1]); w.y = cvt_pk_bf16(y0[2], y0[3]); w.z = cvt_pk_bf16(y1[0], y1[1]); w.w = cvt_pk_bf16(y1[2], y1[3]); *(u32x4*)(ap + 256) = w;
                    w.x = cvt_pk_bf16(z0[0], z0[1]); w.y = cvt_pk_bf16(z0[2], z0[3]); w.z = cvt_pk_bf16(z1[0], z1[1]); w.w = cvt_pk_bf16(z1[2], z1[3]); *(u32x4*)(ap + 384) = w;
                } else {
                    bf16_t* k = KB + (size_t)tok * 2048 + h * 256 + col0;
                    const f32x4 y0 = x1[0] * 0.0625f, y1 = x1[1] * 0.0625f, z0 = x2[0] * 0.0625f, z1 = x2[1] * 0.0625f;
                    u32x4 w; w.x = cvt_pk_bf16(y0[0], y0[1]); w.y = cvt_pk_bf16(y0[2], y0[3]); w.z = cvt_pk_bf16(y1[0], y1[1]); w.w = cvt_pk_bf16(y1[2], y1[3]); *(u32x4*)k = w;
                    w.x = cvt_pk_bf16(z0[0], z0[1]); w.y = cvt_pk_bf16(z0[2], z0[3]); w.z = cvt_pk_bf16(z1[0], z1[1]); w.w = cvt_pk_bf16(z1[2], z1[3]); *(u32x4*)(k + 128) = w;
                    const float zf = __builtin_amdgcn_exp2f(l2f * (float)(255 - j)), zb = __builtin_amdgcn_exp2f(l2b * (float)j);
                    bf16_t* kzf = KZ + ((size_t)(h * 256 + col0)) * T + tok; bf16_t* kzb = kzf + (size_t)2048 * T;
                    const int odd = fr & 1;
#pragma unroll
                    for (int n = 0; n < 2; ++n)
#pragma unroll
                        for (int p = 0; p < 2; ++p) { const float alo = n ? y1[2 * p] : y0[2 * p], ahi = n ? y1[2 * p + 1] : y0[2 * p + 1], blo = n ? z1[2 * p] : z0[2 * p], bhi = n ? z1[2 * p + 1] : z0[2 * p + 1];
                            const size_t o = (size_t)(4 * n + 2 * p + odd) * T - odd;
#pragma unroll
                            for (int dir = 0; dir < 2; ++dir) { const float z = dir ? zb : zf; bf16_t* kz = dir ? kzb : kzf;
                                const float keepa = (odd ? ahi : alo) * z, keepb = (odd ? bhi : blo) * z;
                                const float ra = __shfl_xor((odd ? alo : ahi) * z, 1), rb = __shfl_xor((odd ? blo : bhi) * z, 1);
                                *(unsigned*)(kz + o) = odd ? cvt_pk_bf16(ra, keepa) : cvt_pk_bf16(keepa, ra);
                                *(unsigned*)(kz + o + (size_t)128 * T) = odd ? cvt_pk_bf16(rb, keepb) : cvt_pk_bf16(keepb, rb); } }
                }
                __builtin_amdgcn_sched_barrier(0);
            }
    }
};
struct EpiRetScores {
    static constexpr bool PERM = true;
    bf16_t* AP; const float* decay_logit;
    __device__ __forceinline__ void operator()(const f32x4 (&acc)[2][2][4][2], const Unit& u, int wr, int wc, int fr, int fq) const {
        asm volatile("" : "+v"(fr), "+v"(fq));
        const int h = u.pm >> 6, ci = u.pm & 63; const int row0 = wr * 64 + fr, col0 = wc * 32 + 8 * fq;
        const float l2f = log2_decay(decay_logit, 0, h), l2b = log2_decay(decay_logit, 1, h);
#pragma unroll
        for (int ai = 0; ai < 2; ++ai)
#pragma unroll
            for (int m = 0; m < 4; ++m) { const int n_ = row0 + ai * 128 + m * 16; bf16_t* rowp = AP + ((size_t)h * T + ci * 256 + n_) * 768 + col0;
#pragma unroll
                for (int bj = 0; bj < 2; ++bj) { f32x4 v[2];
#pragma unroll
                    for (int n = 0; n < 2; ++n)
#pragma unroll
                        for (int e = 0; e < 4; ++e) { const int mm = bj * 128 + col0 + 4 * n + e; const float d = (float)(n_ - mm);
                            const float dec = __builtin_amdgcn_exp2f(l2f * fmaxf(d, 0.f) + l2b * fmaxf(-d, 0.f)); v[n][e] = acc[ai][bj][m][n][e] * dec; }
                    u32x4 w; w.x = cvt_pk_bf16(v[0][0], v[0][1]); w.y = cvt_pk_bf16(v[0][2], v[0][3]); w.z = cvt_pk_bf16(v[1][0], v[1][1]); w.w = cvt_pk_bf16(v[1][2], v[1][3]);
                    *(u32x4*)(rowp + bj * 128) = w; }
                __builtin_amdgcn_sched_barrier(0); }
    }
};
struct EpiWqk {
    static constexpr bool PERM = true;
    bf16_t* WQK; unsigned* cmax; float sc;
    __device__ __forceinline__ void operator()(const f32x4 (&acc)[2][2][4][2], const Unit& u, int wr, int wc, int fr, int fq) const {
        asm volatile("" : "+v"(fr), "+v"(fq));
        const int row0 = wr * 64 + fr, col0 = wc * 32 + 8 * fq; const int L = u.pn >> 3;
#pragma unroll
        for (int ai = 0; ai < 2; ++ai)
#pragma unroll
            for (int m = 0; m < 4; ++m) { const int row = u.pm * 256 + row0 + ai * 128 + m * 16; bf16_t* rowp = WQK + (size_t)row * 4096 + u.pn * 256 + col0; float mx = 0.f;
#pragma unroll
                for (int bj = 0; bj < 2; ++bj) { const f32x4 v0 = acc[ai][bj][m][0] * sc, v1 = acc[ai][bj][m][1] * sc;
                    u32x4 w; w.x = cvt_pk_bf16(v0[0], v0[1]); w.y = cvt_pk_bf16(v0[2], v0[3]); w.z = cvt_pk_bf16(v1[0], v1[1]); w.w = cvt_pk_bf16(v1[2], v1[3]);
                    *(u32x4*)(rowp + bj * 128) = w;
                    mx = fmaxf(mx, fmaxf(fmaxf(fabsf(bf_lo(w.x)), fabsf(bf_hi(w.x))), fmaxf(fabsf(bf_lo(w.y)), fabsf(bf_hi(w.y)))));
                    mx = fmaxf(mx, fmaxf(fmaxf(fabsf(bf_lo(w.z)), fabsf(bf_hi(w.z))), fmaxf(fabsf(bf_lo(w.w)), fabsf(bf_hi(w.w))))); }
                mx = fmaxf(mx, __shfl_xor(mx, 16)); mx = fmaxf(mx, __shfl_xor(mx, 32));
                if (fq == 0) atomicMax(cmax + L * 1024 + row, __float_as_uint(mx)); }
    }
};
struct EpiMemKV {
    static constexpr bool PERM = true;
    bf16_t* MK; bf16_t* MV;
    __device__ __forceinline__ void operator()(const f32x4 (&acc)[2][2][4][2], const Unit& u, int wr, int wc, int fr, int fq) const {
        asm volatile("" : "+v"(fr), "+v"(fq));
        const int row0 = wr * 64 + fr, col0 = wc * 32 + 8 * fq;
#pragma unroll
        for (int ai = 0; ai < 2; ++ai)
#pragma unroll
            for (int m = 0; m < 4; ++m) { const int key = row0 + ai * 128 + m * 16;
#pragma unroll
                for (int bj = 0; bj < 2; ++bj) { const int n_ = u.pn * 256 + bj * 128 + col0; const int nn = n_ & 511; const int h = nn >> 7;
                    bf16_t* dst = (n_ < 512 ? MK : MV) + ((size_t)(h * 256 + key)) * 512 + nn;
                    const f32x4 v0 = acc[ai][bj][m][0], v1 = acc[ai][bj][m][1];
                    u32x4 w; w.x = cvt_pk_bf16(v0[0], v0[1]); w.y = cvt_pk_bf16(v0[2], v0[3]); w.z = cvt_pk_bf16(v1[0], v1[1]); w.w = cvt_pk_bf16(v1[2], v1[3]);
                    *(u32x4*)dst = w; } }
    }
};
struct EpiNaQK {
    static constexpr bool PERM = true;
    bf16_t* Q; bf16_t* Kb;
    __device__ __forceinline__ void operator()(const f32x4 (&acc)[2][2][4][2], const Unit& u, int wr, int wc, int fr, int fq) const {
        asm volatile("" : "+v"(fr), "+v"(fq));
        const bool isq = u.pn < 8; const float sc = isq ? 0.08838834764831845f : 1.f;
        const int row0 = wr * 64 + fr, col0 = wc * 32 + 8 * fq;
#pragma unroll
        for (int ai = 0; ai < 2; ++ai)
#pragma unroll
            for (int m = 0; m < 4; ++m) { const int tok = u.pm * 256 + row0 + ai * 128 + m * 16;
#pragma unroll
                for (int bj = 0; bj < 2; ++bj) { const f32x4 v0 = acc[ai][bj][m][0] * sc, v1 = acc[ai][bj][m][1] * sc;
                    u32x4 w; w.x = cvt_pk_bf16(v0[0], v0[1]); w.y = cvt_pk_bf16(v0[2], v0[3]); w.z = cvt_pk_bf16(v1[0], v1[1]); w.w = cvt_pk_bf16(v1[2], v1[3]);
                    const int head = 2 * (u.pn & 7) + bj;
                    bf16_t* dst = isq ? Q + (size_t)tok * 2048 + head * 128 + col0
                                      : Kb + (size_t)head * T * 128 + ((size_t)(tok >> 3) * 16 + (col0 >> 3)) * 64 + (tok & 7) * 8;
                    *(u32x4*)dst = w; } }
    }
};
struct EpiNaV {
    static constexpr bool PERM = true;
    bf16_t* Vb;
    __device__ __forceinline__ void operator()(const f32x4 (&acc)[2][2][4][2], const Unit& u, int wr, int wc, int fr, int fq) const {
        asm volatile("" : "+v"(fr), "+v"(fq));
        const int row0 = wr * 64 + fr, col0 = wc * 32 + 8 * fq;
#pragma unroll
        for (int ai = 0; ai < 2; ++ai)
#pragma unroll
            for (int m = 0; m < 4; ++m) { const int head = 2 * u.pm + ai, d = row0 + m * 16;
#pragma unroll
                for (int bj = 0; bj < 2; ++bj) { const int tok = u.pn * 256 + bj * 128 + col0;
                    bf16_t* dst = Vb + (size_t)head * T * 128 + ((size_t)(tok >> 2) * 128 + d) * 4;
                    const f32x4 v0 = acc[ai][bj][m][0], v1 = acc[ai][bj][m][1];
                    u32x2 a, b; a.x = cvt_pk_bf16(v0[0], v0[1]); a.y = cvt_pk_bf16(v0[2], v0[3]); b.x = cvt_pk_bf16(v1[0], v1[1]); b.y = cvt_pk_bf16(v1[2], v1[3]);
                    *(u32x2*)dst = a; *(u32x2*)(dst + 512) = b; } }
    }
};
__device__ __forceinline__ f32x4 i32_to_f32(f32x4 bits) { const v4i32 i = __builtin_bit_cast(v4i32, bits); return (f32x4){(float)i[0], (float)i[1], (float)i[2], (float)i[3]}; }
struct EpiSwiglu8i {
    static constexpr bool PERM = true;
    bf16_t* base; int ld; const float* rs; const unsigned* cmax;
    __device__ __forceinline__ void operator()(const f32x4 (&acc)[2][2][4][2], const Unit& u, int wr, int wc, int fr, int fq) const {
        asm volatile("" : "+v"(fr), "+v"(fq));
        const int row0 = wr * 64 + fr, col0 = wc * 32 + 8 * fq;
        f32x4 cs[2][2];
#pragma unroll
        for (int bj = 0; bj < 2; ++bj)
#pragma unroll
            for (int n = 0; n < 2; ++n) { const u32x4 c = *(const u32x4*)(cmax + u.pn * 256 + bj * 128 + col0 + 4 * n); cs[bj][n] = (f32x4){__uint_as_float(c.x), __uint_as_float(c.y), __uint_as_float(c.z), __uint_as_float(c.w)} * (1.0f / 127.0f); }
#pragma unroll
        for (int ai = 0; ai < 2; ++ai)
#pragma unroll
            for (int m = 0; m < 4; ++m) { const int row = u.pm * 256 + row0 + ai * 128 + m * 16; const float r = rs[row];
                bf16_t* rowp = base + (size_t)row * ld + (size_t)u.pn * 128 + col0;
                const f32x4 g0 = i32_to_f32(acc[ai][0][m][0]) * cs[0][0] * r, g1 = i32_to_f32(acc[ai][0][m][1]) * cs[0][1] * r, u0 = i32_to_f32(acc[ai][1][m][0]) * cs[1][0] * r, u1 = i32_to_f32(acc[ai][1][m][1]) * cs[1][1] * r;
                f32x4 v0, v1;
#pragma unroll
                for (int e = 0; e < 4; ++e) { v0[e] = silu_f(g0[e]) * u0[e]; v1[e] = silu_f(g1[e]) * u1[e]; }
                u32x4 w; w.x = cvt_pk_bf16(v0[0], v0[1]); w.y = cvt_pk_bf16(v0[2], v0[3]); w.z = cvt_pk_bf16(v1[0], v1[1]); w.w = cvt_pk_bf16(v1[2], v1[3]);
                *(u32x4*)rowp = w; }
    }
};
struct EpiRetQK8 {
    static constexpr bool PERM = true;
    bf16_t* QB; bf16_t* KB; bf16_t* AP; bf16_t* KZ; const float* decay_logit; const float* rs; const unsigned* cmax;
    __device__ __forceinline__ void operator()(const f32x4 (&acc)[2][2][4][2], const Unit& u, int wr, int wc, int fr, int fq) const {
        asm volatile("" : "+v"(fr), "+v"(fq));
        const bool isq = u.pn < 8; const int h = u.pn & 7;
        const int row0 = wr * 64 + fr, col0 = wc * 32 + 8 * fq;
        float rf[2][4]; f32x4 cs[2][2];
#pragma unroll
        for (int n = 0; n < 2; ++n)
#pragma unroll
            for (int e = 0; e < 4; ++e) rf[n][e] = __builtin_amdgcn_exp2f(-(float)(col0 + 4 * n + e) * (13.287712379549449f / 128.0f)) * 0.15915494309189535f;
#pragma unroll
        for (int bj = 0; bj < 2; ++bj)
#pragma unroll
            for (int n = 0; n < 2; ++n) { const u32x4 c = *(const u32x4*)(cmax + u.pn * 256 + bj * 128 + col0 + 4 * n); cs[bj][n] = (f32x4){__uint_as_float(c.x), __uint_as_float(c.y), __uint_as_float(c.z), __uint_as_float(c.w)} * (1.0f / 127.0f); }
        const float l2f = log2_decay(decay_logit, 0, h), l2b = log2_decay(decay_logit, 1, h);
#pragma unroll
        for (int ai = 0; ai < 2; ++ai)
#pragma unroll
            for (int m = 0; m < 4; ++m) {
                const int j = row0 + ai * 128 + m * 16; const int tok = u.pm * 256 + j; const float ftok = (float)tok; const float r = rs[tok];
                f32x4 x1[2], x2[2];
#pragma unroll
                for (int n = 0; n < 2; ++n) { const f32x4 av = i32_to_f32(acc[ai][0][m][n]) * cs[0][n] * r, bv = i32_to_f32(acc[ai][1][m][n]) * cs[1][n] * r;
#pragma unroll
                    for (int e = 0; e < 4; ++e) { const float rev = ftok * rf[n][e]; const float fr_ = rev - floorf(rev);
                        const float sn = __builtin_amdgcn_sinf(fr_), cv = __builtin_amdgcn_cosf(fr_);
                        x1[n][e] = av[e] * cv - bv[e] * sn; x2[n][e] = bv[e] * cv + av[e] * sn; } }
                if (isq) {
                    bf16_t* q = QB + (size_t)tok * 2048 + h * 256 + col0;
                    u32x4 w; w.x = cvt_pk_bf16(x1[0][0], x1[0][1]); w.y = cvt_pk_bf16(x1[0][2], x1[0][3]); w.z = cvt_pk_bf16(x1[1][0], x1[1][1]); w.w = cvt_pk_bf16(x1[1][2], x1[1][3]);
                    *(u32x4*)q = w;
                    w.x = cvt_pk_bf16(x2[0][0], x2[0][1]); w.y = cvt_pk_bf16(x2[0][2], x2[0][3]); w.z = cvt_pk_bf16(x2[1][0], x2[1][1]); w.w = cvt_pk_bf16(x2[1][2], x2[1][3]);
                    *(u32x4*)(q + 128) = w;
                    const float xf = __builtin_amdgcn_exp2f(l2f * (float)(j + 1)), xb = __builtin_amdgcn_exp2f(l2b * (float)(256 - j));
                    bf16_t* ap = AP + ((size_t)h * T + tok) * 768 + 256 + col0;
                    f32x4 y0 = x1[0] * xf, y1 = x1[1] * xf, z0 = x2[0] * xf, z1 = x2[1] * xf;
                    w.x = cvt_pk_bf16(y0[0], y0[1]); w.y = cvt_pk_bf16(y0[2], y0[3]); w.z = cvt_pk_bf16(y1[0], y1[1]); w.w = cvt_pk_bf16(y1[2], y1[3]); *(u32x4*)ap = w;
                    w.x = cvt_pk_bf16(z0[0], z0[1]); w.y = cvt_pk_bf16(z0[2], z0[3]); w.z = cvt_pk_bf16(z1[0], z1[1]); w.w = cvt_pk_bf16(z1[2], z1[3]); *(u32x4*)(ap + 128) = w;
                    y0 = x1[0] * xb; y1 = x1[1] * xb; z0 = x2[0] * xb; z1 = x2[1] * xb;
                    w.x = cvt_pk_bf16(y0[0], y0[1]); w.y = cvt_pk_bf16(y0[2], y0[3]); w.z = cvt_pk_bf16(y1[0], y1[1]); w.w = cvt_pk_bf16(y1[2], y1[3]); *(u32x4*)(ap + 256) = w;
                    w.x = cvt_pk_bf16(z0[0], z0[1]); w.y = cvt_pk_bf16(z0[2], z0[3]); w.z = cvt_pk_bf16(z1[0], z1[1]); w.w = cvt_pk_bf16(z1[2], z1[3]); *(u32x4*)(ap + 384) = w;
                } else {
                    bf16_t* k = KB + (size_t)tok * 2048 + h * 256 + col0;
                    const f32x4 y0 = x1[0] * 0.0625f, y1 = x1[1] * 0.0625f, z0 = x2[0] * 0.0625f, z1 = x2[1] * 0.0625f;
                    u32x4 w; w.x = cvt_pk_bf16(y0[0], y0[1]); w.y = cvt_pk_bf16(y0[2], y0[3]); w.z = cvt_pk_bf16(y1[0], y1[1]); w.w = cvt_pk_bf16(y1[2], y1[3]); *(u32x4*)k = w;
                    w.x = cvt_pk_bf16(z0[0], z0[1]); w.y = cvt_pk_bf16(z0[2], z0[3]); w.z = cvt_pk_bf16(z1[0], z1[1]); w.w = cvt_pk_bf16(z1[2], z1[3]); *(u32x4*)(k + 128) = w;
                    const float zf = __builtin_amdgcn_exp2f(l2f * (float)(255 - j)), zb = __builtin_amdgcn_exp2f(l2b * (float)j);
                    bf16_t* kzf = KZ + ((size_t)(h * 256 + col0)) * T + tok; bf16_t* kzb = kzf + (size_t)2048 * T;
                    const int odd = fr & 1;
#pragma unroll
                    for (int n = 0; n < 2; ++n)
#pragma unroll
                        for (int p = 0; p < 2; ++p) { const float alo = n ? y1[2 * p] : y0[2 * p], ahi = n ? y1[2 * p + 1] : y0[2 * p + 1], blo = n ? z1[2 * p] : z0[2 * p], bhi = n ? z1[2 * p + 1] : z0[2 * p + 1];
                            const size_t o = (size_t)(4 * n + 2 * p + odd) * T - odd;
#pragma unroll
                            for (int dir = 0; dir < 2; ++dir) { const float z = dir ? zb : zf; bf16_t* kz = dir ? kzb : kzf;
                                const float keepa = (odd ? ahi : alo) * z, keepb = (odd ? bhi : blo) * z;
                                const float ra = __shfl_xor((odd ? alo : ahi) * z, 1), rb = __shfl_xor((odd ? blo : bhi) * z, 1);
                                *(unsigned*)(kz + o) = odd ? cvt_pk_bf16(ra, keepa) : cvt_pk_bf16(keepa, ra);
                                *(unsigned*)(kz + o + (size_t)128 * T) = odd ? cvt_pk_bf16(rb, keepb) : cvt_pk_bf16(keepb, rb); } }
                }
                __builtin_amdgcn_sched_barrier(0);
            }
    }
};
struct EpiSilu8i {
    static constexpr bool PERM = true;
    bf16_t* GB; const float* rs; const unsigned* cmax;
    __device__ __forceinline__ void operator()(const f32x4 (&acc)[2][2][4][2], const Unit& u, int wr, int wc, int fr, int fq) const {
        asm volatile("" : "+v"(fr), "+v"(fq));
        const int row0 = wr * 64 + fr, col0 = wc * 32 + 8 * fq;
        f32x4 cs[2][2];
#pragma unroll
        for (int bj = 0; bj < 2; ++bj)
#pragma unroll
            for (int n = 0; n < 2; ++n) { const u32x4 c = *(const u32x4*)(cmax + u.pn * 256 + bj * 128 + col0 + 4 * n); cs[bj][n] = (f32x4){__uint_as_float(c.x), __uint_as_float(c.y), __uint_as_float(c.z), __uint_as_float(c.w)} * (1.0f / 127.0f); }
#pragma unroll
        for (int ai = 0; ai < 2; ++ai)
#pragma unroll
            for (int m = 0; m < 4; ++m) { const int tok = u.pm * 256 + row0 + ai * 128 + m * 16; const float r = rs[tok]; bf16_t* rowp = GB + (size_t)tok * 4096 + u.pn * 256 + col0;
#pragma unroll
                for (int bj = 0; bj < 2; ++bj) { f32x4 v0 = i32_to_f32(acc[ai][bj][m][0]) * cs[bj][0] * r, v1 = i32_to_f32(acc[ai][bj][m][1]) * cs[bj][1] * r;
#pragma unroll
                    for (int e = 0; e < 4; ++e) { v0[e] = silu_f(v0[e]); v1[e] = silu_f(v1[e]); }
                    u32x4 w; w.x = cvt_pk_bf16(v0[0], v0[1]); w.y = cvt_pk_bf16(v0[2], v0[3]); w.z = cvt_pk_bf16(v1[0], v1[1]); w.w = cvt_pk_bf16(v1[2], v1[3]);
                    *(u32x4*)(rowp + bj * 128) = w; } }
    }
};
struct EpiRetV8 {
    static constexpr bool PERM = true;
    bf16_t* BS; const float* rs; const unsigned* cmax;
    __device__ __forceinline__ void operator()(const f32x4 (&acc)[2][2][4][2], const Unit& u, int wr, int wc, int fr, int fq) const {
        asm volatile("" : "+v"(fr), "+v"(fq));
        const int row0 = wr * 64 + fr, col0 = wc * 32 + 8 * fq;
        bf16_t* base = BS + (((size_t)(u.pm >> 1) * 64 + u.pn) * 512 + (u.pm & 1) * 256) * 768;
        f32x4 rc[2][2];
#pragma unroll
        for (int bj = 0; bj < 2; ++bj) { rc[bj][0] = *(const f32x4*)(rs + u.pn * 256 + bj * 128 + col0); rc[bj][1] = *(const f32x4*)(rs + u.pn * 256 + bj * 128 + col0 + 4); }
#pragma unroll
        for (int ai = 0; ai < 2; ++ai)
#pragma unroll
            for (int m = 0; m < 4; ++m) { const int r_ = row0 + ai * 128 + m * 16; const float cw = __uint_as_float(cmax[4096 + u.pm * 256 + r_]) * (1.0f / 127.0f);
                bf16_t* rowp = base + (size_t)r_ * 768 + col0;
#pragma unroll
                for (int bj = 0; bj < 2; ++bj) { const f32x4 v0 = i32_to_f32(acc[ai][bj][m][0]) * rc[bj][0] * cw, v1 = i32_to_f32(acc[ai][bj][m][1]) * rc[bj][1] * cw;
                    u32x4 w; w.x = cvt_pk_bf16(v0[0], v0[1]); w.y = cvt_pk_bf16(v0[2], v0[3]); w.z = cvt_pk_bf16(v1[0], v1[1]); w.w = cvt_pk_bf16(v1[2], v1[3]);
                    *(u32x4*)(rowp + bj * 128) = w; } }
    }
};
struct EpiNaQK8 {
    static constexpr bool PERM = true;
    bf16_t* Q; bf16_t* Kb; const float* rs; const unsigned* cmax;
    __device__ __forceinline__ void operator()(const f32x4 (&acc)[2][2][4][2], const Unit& u, int wr, int wc, int fr, int fq) const {
        asm volatile("" : "+v"(fr), "+v"(fq));
        const bool isq = u.pn < 8; const float sc0 = (isq ? 0.08838834764831845f : 1.f) * (1.0f / 127.0f);
        const int row0 = wr * 64 + fr, col0 = wc * 32 + 8 * fq;
        f32x4 cs[2][2];
#pragma unroll
        for (int bj = 0; bj < 2; ++bj)
#pragma unroll
            for (int n = 0; n < 2; ++n) { const u32x4 c = *(const u32x4*)(cmax + u.pn * 256 + bj * 128 + col0 + 4 * n); cs[bj][n] = (f32x4){__uint_as_float(c.x), __uint_as_float(c.y), __uint_as_float(c.z), __uint_as_float(c.w)} * sc0; }
#pragma unroll
        for (int ai = 0; ai < 2; ++ai)
#pragma unroll
            for (int m = 0; m < 4; ++m) { const int tok = u.pm * 256 + row0 + ai * 128 + m * 16; const float r = rs[tok];
#pragma unroll
                for (int bj = 0; bj < 2; ++bj) { const f32x4 v0 = i32_to_f32(acc[ai][bj][m][0]) * cs[bj][0] * r, v1 = i32_to_f32(acc[ai][bj][m][1]) * cs[bj][1] * r;
                    u32x4 w; w.x = cvt_pk_bf16(v0[0], v0[1]); w.y = cvt_pk_bf16(v0[2], v0[3]); w.z = cvt_pk_bf16(v1[0], v1[1]); w.w = cvt_pk_bf16(v1[2], v1[3]);
                    const int head = 2 * (u.pn & 7) + bj;
                    bf16_t* dst = isq ? Q + (size_t)tok * 2048 + head * 128 + col0
                                      : Kb + (size_t)head * T * 128 + ((size_t)(tok >> 3) * 16 + (col0 >> 3)) * 64 + (tok & 7) * 8;
                    *(u32x4*)dst = w; } }
    }
};
struct EpiNaV8 {
    static constexpr bool PERM = true;
    bf16_t* Vb; const float* rs; const unsigned* cmax;
    __device__ __forceinline__ void operator()(const f32x4 (&acc)[2][2][4][2], const Unit& u, int wr, int wc, int fr, int fq) const {
        asm volatile("" : "+v"(fr), "+v"(fq));
        const int row0 = wr * 64 + fr, col0 = wc * 32 + 8 * fq;
        f32x4 rc[2][2];
#pragma unroll
        for (int bj = 0; bj < 2; ++bj) { rc[bj][0] = *(const f32x4*)(rs + u.pn * 256 + bj * 128 + col0); rc[bj][1] = *(const f32x4*)(rs + u.pn * 256 + bj * 128 + col0 + 4); }
#pragma unroll
        for (int ai = 0; ai < 2; ++ai)
#pragma unroll
            for (int m = 0; m < 4; ++m) { const int head = 2 * u.pm + ai, d = row0 + m * 16;
                const float cw = __uint_as_float(cmax[4096 + u.pm * 256 + ai * 128 + d]) * (1.0f / 127.0f);
#pragma unroll
                for (int bj = 0; bj < 2; ++bj) { const int tok = u.pn * 256 + bj * 128 + col0;
                    bf16_t* dst = Vb + (size_t)head * T * 128 + ((size_t)(tok >> 2) * 128 + d) * 4;
                    const f32x4 v0 = i32_to_f32(acc[ai][bj][m][0]) * rc[bj][0] * cw, v1 = i32_to_f32(acc[ai][bj][m][1]) * rc[bj][1] * cw;
                    u32x2 a, b; a.x = cvt_pk_bf16(v0[0], v0[1]); a.y = cvt_pk_bf16(v0[2], v0[3]); b.x = cvt_pk_bf16(v1[0], v1[1]); b.y = cvt_pk_bf16(v1[2], v1[3]);
                    *(u32x2*)dst = a; *(u32x2*)(dst + 512) = b; } }
    }
};
struct EpiXaSoftmax {
    static constexpr bool PERM = true;
    bf16_t* XP; LAS unsigned char* ex; const float* rs; const unsigned* cmax;
    __device__ __forceinline__ void operator()(const f32x4 (&acc)[2][2][4][2], const Unit& u, int wr, int wc, int fr, int fq) const {
        asm volatile("" : "+v"(fr), "+v"(fq));
        const int row0 = wr * 64 + fr, col0 = wc * 32 + 8 * fq;
        LAS f32x2* X = (LAS f32x2*)ex;
        f32x4 cs[2][2];
#pragma unroll
        for (int bj = 0; bj < 2; ++bj)
#pragma unroll
            for (int n = 0; n < 2; ++n) { const u32x4 c = *(const u32x4*)(cmax + u.pn * 256 + bj * 128 + col0 + 4 * n); cs[bj][n] = (f32x4){__uint_as_float(c.x), __uint_as_float(c.y), __uint_as_float(c.z), __uint_as_float(c.w)} * (1.0f / 127.0f); }
        float mw[2][4], p[2][4][2][2][4];
#pragma unroll
        for (int ai = 0; ai < 2; ++ai)
#pragma unroll
            for (int m = 0; m < 4; ++m) {
                const float r = rs[u.pm * 256 + row0 + ai * 128 + m * 16];
                f32x4 sv[2][2];
#pragma unroll
                for (int bj = 0; bj < 2; ++bj)
#pragma unroll
                    for (int n = 0; n < 2; ++n) sv[bj][n] = i32_to_f32(acc[ai][bj][m][n]) * cs[bj][n] * r;
                float mx = -3.0e38f;
#pragma unroll
                for (int bj = 0; bj < 2; ++bj)
#pragma unroll
                    for (int n = 0; n < 2; ++n)
#pragma unroll
                        for (int e = 0; e < 4; ++e) mx = fmaxf(mx, sv[bj][n][e]);
                mx = fmaxf(mx, __shfl_xor(mx, 16)); mx = fmaxf(mx, __shfl_xor(mx, 32));
                float s = 0.f;
#pragma unroll
                for (int bj = 0; bj < 2; ++bj)
#pragma unroll
                    for (int n = 0; n < 2; ++n)
#pragma unroll
                        for (int e = 0; e < 4; ++e) { const float q = fast_exp(sv[bj][n][e] - mx); p[ai][m][bj][n][e] = q; s += q; }
                s += __shfl_xor(s, 16); s += __shfl_xor(s, 32);
                mw[ai][m] = mx;
                if (fq == 0) X[(row0 + ai * 128 + m * 16) * 4 + wc] = (f32x2){mx, s};
            }
        LDS_WAIT(); __builtin_amdgcn_s_barrier(); asm volatile("" ::: "memory");
#pragma unroll
        for (int ai = 0; ai < 2; ++ai)
#pragma unroll
            for (int m = 0; m < 4; ++m) {
                const int r = row0 + ai * 128 + m * 16;
                const f32x2 a = X[r * 4 + 0], b = X[r * 4 + 1], c = X[r * 4 + 2], d = X[r * 4 + 3];
                const float M = fmaxf(fmaxf(a.x, b.x), fmaxf(c.x, d.x));
                const float tot = a.y * fast_exp(a.x - M) + b.y * fast_exp(b.x - M) + c.y * fast_exp(c.x - M) + d.y * fast_exp(d.x - M);
                const float f = fast_exp(mw[ai][m] - M) * __builtin_amdgcn_rcpf(tot);
                bf16_t* rowp = XP + (size_t)(u.pm * 256 + r) * 1024 + u.pn * 256 + col0;
#pragma unroll
                for (int bj = 0; bj < 2; ++bj) { u32x4 w;
                    w.x = cvt_pk_bf16(p[ai][m][bj][0][0] * f, p[ai][m][bj][0][1] * f); w.y = cvt_pk_bf16(p[ai][m][bj][0][2] * f, p[ai][m][bj][0][3] * f);
                    w.z = cvt_pk_bf16(p[ai][m][bj][1][0] * f, p[ai][m][bj][1][1] * f); w.w = cvt_pk_bf16(p[ai][m][bj][1][2] * f, p[ai][m][bj][1][3] * f);
                    *(u32x4*)(rowp + bj * 128) = w; }
            }
        LDS_WAIT(); __builtin_amdgcn_s_barrier(); asm volatile("" ::: "memory");
    }
};

struct Args { const float* in[22]; float* out; unsigned char* ws; };
struct Frame {
    LAS unsigned char* lds; volatile LAS unsigned* MISC;
    int wave, G, gw, NGW;
};

struct AdSimple { bf16_t* base; int ld; float sc; int colw;
    __device__ __forceinline__ bf16_t* operator()(const Unit& u, int& ldc, float& s) const { ldc = ld; s = sc; return base + (size_t)u.pm * 256 * ld + (size_t)u.pn * colw; } };
struct AdRetV { bf16_t* BS;
    __device__ __forceinline__ bf16_t* operator()(const Unit& u, int& ldc, float& s) const { ldc = 768; s = 1.f; return BS + (((size_t)(u.pm >> 1) * 64 + u.pn) * 512 + (u.pm & 1) * 256) * 768; } };
struct AdRetKV { bf16_t* BS;
    __device__ __forceinline__ bf16_t* operator()(const Unit& u, int& ldc, float& s) const { ldc = 768; s = 1.f; return BS + ((size_t)(u.pm >> 1) * 512 + (u.pm & 1) * 256) * 768 + 256 + u.pn * 256; } };
struct AdRetY { bf16_t* Y;
    __device__ __forceinline__ bf16_t* operator()(const Unit& u, int& ldc, float& s) const { ldc = 4096; s = 1.f; return Y + (size_t)(u.pm & 63) * 256 * 4096 + (u.pm >> 6) * 512 + u.pn * 256; } };
struct AdNaQK { bf16_t* Q; bf16_t* Kk;
    __device__ __forceinline__ bf16_t* operator()(const Unit& u, int& ldc, float& s) const { ldc = 2048; s = u.pn < 8 ? 0.08838834764831845f : 1.f; return (u.pn < 8 ? Q : Kk) + (size_t)u.pm * 256 * 2048 + (u.pn & 7) * 256; } };
struct AdMoe { bf16_t* base; int ld; int colw; float sc;
    __device__ __forceinline__ bf16_t* operator()(const Unit& u, int& ldc, float& s) const { ldc = ld; s = sc; return base + (size_t)u.pm * 256 * ld + (size_t)u.pn * colw; } };

struct MapAB { const bf16_t* A; const bf16_t* B; size_t sa, sb;
    __device__ __forceinline__ void operator()(const Unit& u, const char*& a, const char*& b) const { a = (const char*)(A + (size_t)u.pm * sa); b = (const char*)(B + (size_t)u.pn * sb); } };
struct MapAB8 { const unsigned char* A; const unsigned char* B; size_t sa, sb;
    __device__ __forceinline__ void operator()(const Unit& u, const char*& a, const char*& b) const { a = (const char*)(A + (size_t)u.pm * sa); b = (const char*)(B + (size_t)u.pn * sb); } };
struct MapRetS { const bf16_t* Q; const bf16_t* Kk;
    __device__ __forceinline__ void operator()(const Unit& u, const char*& a, const char*& b) const { const size_t o = (size_t)(u.pm & 63) * 256 * 2048 + (u.pm >> 6) * 256; a = (const char*)(Q + o); b = (const char*)(Kk + o); } };
struct MapRetKV { const bf16_t* BS; const bf16_t* KZ;
    __device__ __forceinline__ void operator()(const Unit& u, const char*& a, const char*& b) const { const int hc = u.pm >> 1, h = hc >> 6, ci = hc & 63;
        a = (const char*)(BS + ((size_t)hc * 512 + (u.pm & 1) * 256) * 768); b = (const char*)(KZ + ((size_t)(u.pn * 2048 + h * 256)) * T + ci * 256); } };
struct MapRetO { const bf16_t* AP; const bf16_t* BS;
    __device__ __forceinline__ void operator()(const Unit& u, const char*& a, const char*& b) const { const int h = u.pm >> 6, ci = u.pm & 63;
        a = (const char*)(AP + ((size_t)h * T + ci * 256) * 768); b = (const char*)(BS + ((size_t)u.pm * 512 + u.pn * 256) * 768); } };
struct MapMoe { const unsigned char* A; const unsigned char* W; size_t sa, se, sb; const volatile LAS unsigned* ts;
    __device__ __forceinline__ void operator()(const Unit& u, const char*& a, const char*& b) const { int e = 0;
#pragma unroll
        for (int j = 1; j < 8; ++j) e += (__builtin_amdgcn_readfirstlane((int)ts[j]) <= u.pm) ? 1 : 0;
        a = (const char*)(A + (size_t)u.pm * sa); b = (const char*)(W + (size_t)e * se + (size_t)u.pn * sb); } };

struct MapMoeD { const unsigned char* A; const unsigned char* W; const volatile LAS unsigned* ts;
    __device__ __forceinline__ void operator()(const Unit& u, const char*& a, const char*& b) const { int e = 0;
#pragma unroll
        for (int j = 1; j < 8; ++j) e += (__builtin_amdgcn_readfirstlane((int)ts[j]) <= u.pm) ? 1 : 0;
        const size_t ko = u.kq < 0 ? 0 : (size_t)u.kq * (EDIM / 4);
        a = (const char*)(A + (size_t)u.pm * 256 * EDIM + ko); b = (const char*)(W + ((size_t)e * 2048 + (size_t)u.pn * 256) * EDIM + ko); } };
struct EpiMoeDown {
    static constexpr bool PERM = true;
    bf16_t* Y; bf16_t* YP; int tail_row0;
    __device__ __forceinline__ void operator()(const f32x4 (&acc)[2][2][4][2], const Unit& u, int wr, int wc, int fr, int fq) const {
        asm volatile("" : "+v"(fr), "+v"(fq));
        bf16_t* base = u.kq < 0 ? Y + (size_t)u.pm * 256 * 2048 + u.pn * 256 : YP + ((size_t)u.kq * 2048 + (size_t)(u.pm * 256 - tail_row0)) * 2048 + u.pn * 256;
        const int row0 = wr * 64 + fr, col0 = wc * 32 + 8 * fq;
#pragma unroll
        for (int ai = 0; ai < 2; ++ai)
#pragma unroll
            for (int m = 0; m < 4; ++m) { bf16_t* rowp = base + (size_t)(row0 + ai * 128 + m * 16) * 2048 + col0;
#pragma unroll
                for (int bj = 0; bj < 2; ++bj) { const f32x4 v0 = acc[ai][bj][m][0] * 0.015625f, v1 = acc[ai][bj][m][1] * 0.015625f;
                    u32x4 w; w.x = cvt_pk_bf16(v0[0], v0[1]); w.y = cvt_pk_bf16(v0[2], v0[3]); w.z = cvt_pk_bf16(v1[0], v1[1]); w.w = cvt_pk_bf16(v1[2], v1[3]);
                    *(u32x4*)(rowp + bj * 128) = w; } }
    }
};

__device__ __forceinline__ void transpose_item(const float* W, int N, int k0, int n0, bf16_t* dst, int ldd, LAS unsigned* scr, int lane) {
    const int kp = lane >> 4, nq = lane & 15;
    f32x4 a[8], b[8];
#pragma unroll
    for (int it = 0; it < 8; ++it) { const float* p = W + (size_t)(k0 + 8 * it + 2 * kp) * N + n0 + 4 * nq; a[it] = *(const f32x4*)p; b[it] = *(const f32x4*)(p + N); }
#pragma unroll
    for (int it = 0; it < 8; ++it)
#pragma unroll
        for (int e = 0; e < 4; ++e) scr[(4 * nq + e) * 33 + 4 * it + kp] = cvt_pk_bf16(a[it][e], b[it][e]);
    LDS_WAIT(); asm volatile("" ::: "memory");
    const int nr = lane >> 3, c = lane & 7;
#pragma unroll
    for (int ps = 0; ps < 8; ++ps) { const int n = 8 * ps + nr; u32x4 w; w.x = scr[n * 33 + 4 * c]; w.y = scr[n * 33 + 4 * c + 1]; w.z = scr[n * 33 + 4 * c + 2]; w.w = scr[n * 33 + 4 * c + 3];
        *(u32x4*)(dst + (size_t)n * ldd + 8 * c) = w; }
    LDS_WAIT(); asm volatile("" ::: "memory");
}
__device__ __forceinline__ void conv_job(Frame& F, const float* W, int K, int N, bf16_t* WT, int ldd, int mode, int row_off, int rot) {
    int tid_ = tid_now(F.wave); asm volatile("" : "+v"(tid_)); const int lane_ = tid_ & 63;
    LAS unsigned* scr = (LAS unsigned*)(F.lds + F.wave * 8448);
    const int nnb = N / 64, nitems = (K / 64) * nnb;
    int g0 = F.gw + rot; if (g0 >= F.NGW) g0 -= F.NGW;
    for (int it = g0; it < nitems; it += F.NGW) { const int kb = it / nnb, nb = it % nnb; const int n0 = nb * 64;
        const int r0 = mode ? ((n0 >> 7) * 256 + (n0 & 127) + row_off) : (row_off + n0);
        transpose_item(W, N, kb * 64, n0, WT + (size_t)r0 * ldd + kb * 64, ldd, scr, lane_); }
}
__device__ __forceinline__ void t8_load(const float* W, int N, int k0, int n0, int lane, f32x4 (&a)[8], f32x4 (&b)[8]) {
    const int kq = lane >> 4, nq = lane & 15;
#pragma unroll
    for (int it = 0; it < 4; ++it) { const float* p = W + (size_t)(k0 + 16 * it + 4 * kq) * N + n0 + 4 * nq;
        a[2 * it] = __builtin_nontemporal_load((const f32x4*)p); b[2 * it] = __builtin_nontemporal_load((const f32x4*)(p + N));
        a[2 * it + 1] = __builtin_nontemporal_load((const f32x4*)(p + 2 * (size_t)N)); b[2 * it + 1] = __builtin_nontemporal_load((const f32x4*)(p + 3 * (size_t)N)); }
}
__device__ __forceinline__ void t8_finish(const f32x4 (&a)[8], const f32x4 (&b)[8], unsigned char* dst, int ldd, float scale, LAS unsigned* scr, int lane) {
    const int kq = lane >> 4, nq = lane & 15;
#pragma unroll
    for (int it = 0; it < 4; ++it)
#pragma unroll
        for (int e = 0; e < 4; ++e) scr[(4 * nq + e) * 17 + 4 * it + kq] = pk4_fp8(a[2 * it][e] * scale, b[2 * it][e] * scale, a[2 * it + 1][e] * scale, b[2 * it + 1][e] * scale);
    LDS_WAIT(); asm volatile("" ::: "memory");
    const int nr = lane >> 2, c = lane & 3;
#pragma unroll
    for (int ps = 0; ps < 4; ++ps) { const int n = 16 * ps + nr; u32x4 w; w.x = scr[n * 17 + 4 * c]; w.y = scr[n * 17 + 4 * c + 1]; w.z = scr[n * 17 + 4 * c + 2]; w.w = scr[n * 17 + 4 * c + 3];
        *(u32x4*)(dst + (size_t)n * ldd + 16 * c) = w; }
    LDS_WAIT(); asm volatile("" ::: "memory");
}
__device__ __forceinline__ void conv_job8(Frame& F, const float* W, int K, int N, unsigned char* WT, int ldd, int mode, int row_off, float scale) {
    int tid_ = tid_now(F.wave); asm volatile("" : "+v"(tid_)); const int lane_ = tid_ & 63;
    LAS unsigned* scr = (LAS unsigned*)(F.lds + F.wave * 8448);
    const int nnb = N / 64, nitems = (K / 64) * nnb;
#define T8_DST(it_) (WT + (size_t)(mode ? (((((it_) % nnb) * 64) >> 7) * 256 + ((((it_) % nnb) * 64) & 127) + row_off) : (row_off + ((it_) % nnb) * 64)) * ldd + ((it_) / nnb) * 64)
    f32x4 a0[8], b0[8], a1[8], b1[8];
    int it = F.gw;
    if (it < nitems) t8_load(W, N, (it / nnb) * 64, (it % nnb) * 64, lane_, a0, b0);
    while (it < nitems) {
        const int it1 = it + F.NGW, it2 = it1 + F.NGW;
        if (it1 < nitems) t8_load(W, N, (it1 / nnb) * 64, (it1 % nnb) * 64, lane_, a1, b1);
        t8_finish(a0, b0, T8_DST(it), ldd, scale, scr, lane_);
        if (it1 >= nitems) break;
        if (it2 < nitems) t8_load(W, N, (it2 / nnb) * 64, (it2 % nnb) * 64, lane_, a0, b0);
        t8_finish(a1, b1, T8_DST(it1), ldd, scale, scr, lane_);
        it = it2;
    }
#undef T8_DST
}
__device__ __forceinline__ void t16_load(const float* W, int N, int k0, int n0, int lane, f32x4 (&a)[8], f32x4 (&b)[8]) {
    const int kp = lane >> 4, nq = lane & 15;
#pragma unroll
    for (int it = 0; it < 8; ++it) { const float* p = W + (size_t)(k0 + 8 * it + 2 * kp) * N + n0 + 4 * nq; a[it] = __builtin_nontemporal_load((const f32x4*)p); b[it] = __builtin_nontemporal_load((const f32x4*)(p + N)); }
}
__device__ __forceinline__ void t16_finish(const f32x4 (&a)[8], const f32x4 (&b)[8], bf16_t* dst, int ldd, LAS unsigned* scr, int lane) {
    const int kp = lane >> 4, nq = lane & 15;
#pragma unroll
    for (int it = 0; it < 8; ++it)
#pragma unroll
        for (int e = 0; e < 4; ++e) scr[(4 * nq + e) * 33 + 4 * it + kp] = cvt_pk_bf16(a[it][e], b[it][e]);
    LDS_WAIT(); asm volatile("" ::: "memory");
    const int nr = lane >> 3, c = lane & 7;
#pragma unroll
    for (int ps = 0; ps < 8; ++ps) { const int n = 8 * ps + nr; u32x4 w; w.x = scr[n * 33 + 4 * c]; w.y = scr[n * 33 + 4 * c + 1]; w.z = scr[n * 33 + 4 * c + 2]; w.w = scr[n * 33 + 4 * c + 3];
        *(u32x4*)(dst + (size_t)n * ldd + 8 * c) = w; }
    LDS_WAIT(); asm volatile("" ::: "memory");
}
struct CvPtrs { const float *ret_in, *ret_out, *ffn_g, *ffn_u, *ffn_d, *na_in, *na_out, *xa_out, *memkv; unsigned char* ws; };
__device__ __forceinline__ void conv_all_p0(Frame& F, const CvPtrs P) {
    int tid_ = tid_now(F.wave); asm volatile("" : "+v"(tid_)); const int lane_ = tid_ & 63;
    LAS unsigned* scr = (LAS unsigned*)(F.lds + F.wave * 8448);
    constexpr int TOTAL = 6912;
#define CV_CASE(first_, src_, N__, nnb__, dstoff_, ld__, md__, ro__) if (j_ >= (first_)) { f_ = (first_); Wb_ = (src_); Nn_ = (N__); nb_ = (nnb__); db_ = (bf16_t*)(P.ws + (dstoff_)); ld_ = (ld__); md_ = (md__); ro_ = (ro__); }
#define CV_DECODE(jj_, W_, N_, k0_, n0_, dst_, ldd_) do { const int j_ = (jj_); int f_ = 0, Nn_ = 2048, nb_ = 32, ld_ = 4096, md_ = 0, ro_ = 0; const float* Wb_ = P.ret_out; bf16_t* db_ = (bf16_t*)(P.ws + WS_W_RETOUT); \
        CV_CASE(2048, P.ffn_d, 2048, 32, WS_W_FFND, FFN, 0, 0) CV_CASE(4864, P.na_out, 2048, 32, WS_W_NAOUT, 2048, 0, 0) \
        CV_CASE(5888, P.xa_out, 2048, 32, WS_W_XOT, 512, 0, 0) CV_CASE(6144, P.xa_out + 512 * 2048, 2048, 32, WS_W_XOT + (size_t)2048 * 512 * 2, 512, 0, 0) CV_CASE(6400, P.memkv, 1024, 16, WS_W_MEMKV, 2048, 0, 0) \
        const int r_ = j_ - f_, kb_ = r_ / nb_, nbi_ = r_ % nb_; W_ = Wb_; N_ = Nn_; k0_ = kb_ * 64; n0_ = nbi_ * 64; ldd_ = ld_; \
        dst_ = db_ + (size_t)(md_ ? ((n0_ >> 7) * 256 + (n0_ & 127) + ro_) : (ro_ + n0_)) * ld_ + k0_; } while (0)
    f32x4 a0[8], b0[8], a1[8], b1[8];
    const float* W0; const float* W1; int N0, N1, k0, k1, n0, n1, l0, l1; bf16_t* d0; bf16_t* d1;
    int j = F.gw;
    if (j < TOTAL) { CV_DECODE(j, W0, N0, k0, n0, d0, l0); t16_load(W0, N0, k0, n0, lane_, a0, b0); }
    while (j < TOTAL) {
        const int ja = j + F.NGW, jb = ja + F.NGW;
        if (ja < TOTAL) { CV_DECODE(ja, W1, N1, k1, n1, d1, l1); t16_load(W1, N1, k1, n1, lane_, a1, b1); }
        t16_finish(a0, b0, d0, l0, scr, lane_);
        if (ja >= TOTAL) break;
        if (jb < TOTAL) { CV_DECODE(jb, W0, N0, k0, n0, d0, l0); t16_load(W0, N0, k0, n0, lane_, a0, b0); }
        t16_finish(a1, b1, d1, l1, scr, lane_);
        j = jb;
    }
#undef CV_DECODE
#undef CV_CASE
}
__device__ __forceinline__ void colmax_item(const f32x4 (&a)[8], const f32x4 (&b)[8], unsigned* cmax_row0, int lane) {
    const int nq = lane & 15; f32x4 m = (f32x4){0.f, 0.f, 0.f, 0.f};
#pragma unroll
    for (int it = 0; it < 8; ++it)
#pragma unroll
        for (int e = 0; e < 4; ++e) m[e] = fmaxf(m[e], fmaxf(fabsf(a[it][e]), fabsf(b[it][e])));
#pragma unroll
    for (int e = 0; e < 4; ++e) { m[e] = fmaxf(m[e], __shfl_xor(m[e], 16)); m[e] = fmaxf(m[e], __shfl_xor(m[e], 32)); }
    if (lane < 16) {
#pragma unroll
        for (int e = 0; e < 4; ++e) atomicMax(cmax_row0 + 4 * nq + e, __float_as_uint(m[e])); }
}
__device__ __forceinline__ void q8_finish(const f32x4 (&a)[8], const f32x4 (&b)[8], unsigned char* dst, int ldd, const unsigned* cmax_row0, LAS unsigned* scr, int lane) {
    const int kq = lane >> 4, nq = lane & 15;
    const u32x4 cm = *(const u32x4*)(cmax_row0 + 4 * nq);
    const float inv[4] = {cm.x ? 127.0f / __uint_as_float(cm.x) : 0.f, cm.y ? 127.0f / __uint_as_float(cm.y) : 0.f, cm.z ? 127.0f / __uint_as_float(cm.z) : 0.f, cm.w ? 127.0f / __uint_as_float(cm.w) : 0.f};
#pragma unroll
    for (int it = 0; it < 4; ++it)
#pragma unroll
        for (int e = 0; e < 4; ++e) scr[(4 * nq + e) * 17 + 4 * it + kq] = pk4_i8((f32x4){a[2 * it][e], b[2 * it][e], a[2 * it + 1][e], b[2 * it + 1][e]}, inv[e]);
    LDS_WAIT(); asm volatile("" ::: "memory");
    const int nr = lane >> 2, c = lane & 3;
#pragma unroll
    for (int ps = 0; ps < 4; ++ps) { const int n = 16 * ps + nr; u32x4 w; w.x = scr[n * 17 + 4 * c]; w.y = scr[n * 17 + 4 * c + 1]; w.z = scr[n * 17 + 4 * c + 2]; w.w = scr[n * 17 + 4 * c + 3];
        *(u32x4*)(dst + (size_t)n * ldd + 16 * c) = w; }
    LDS_WAIT(); asm volatile("" ::: "memory");
}
template <bool QUANT>
__device__ __forceinline__ void i8_job(Frame& F, const float* W, int K, int N, unsigned char* W8, int ldd, int mode, int row_off, unsigned* cmax, int rot) {
    int tid_ = tid_now(F.wave); asm volatile("" : "+v"(tid_)); const int lane_ = tid_ & 63;
    LAS unsigned* scr = (LAS unsigned*)(F.lds + F.wave * 8448);
    const int nnb = N / 64, nitems = (K / 64) * nnb;
#define I8_ROW0(it_) (mode ? (((((it_) % nnb) * 64) >> 7) * 256 + ((((it_) % nnb) * 64) & 127) + row_off) : (row_off + ((it_) % nnb) * 64))
#define I8_DO(a_, b_, it_) do { if constexpr (QUANT) q8_finish(a_, b_, W8 + (size_t)I8_ROW0(it_) * ldd + ((it_) / nnb) * 64, ldd, cmax + I8_ROW0(it_), scr, lane_); else colmax_item(a_, b_, cmax + I8_ROW0(it_), lane_); } while (0)
    f32x4 a0[8], b0[8], a1[8], b1[8];
    int it = F.gw + rot; if (it >= F.NGW) it -= F.NGW;
    if (it < nitems) t8_load(W, N, (it / nnb) * 64, (it % nnb) * 64, lane_, a0, b0);
    while (it < nitems) {
        const int it1 = it + F.NGW, it2 = it1 + F.NGW;
        if (it1 < nitems) t8_load(W, N, (it1 / nnb) * 64, (it1 % nnb) * 64, lane_, a1, b1);
        I8_DO(a0, b0, it);
        if (it1 >= nitems) break;
        if (it2 < nitems) t8_load(W, N, (it2 / nnb) * 64, (it2 % nnb) * 64, lane_, a0, b0);
        I8_DO(a1, b1, it1);
        it = it2;
    }
#undef I8_DO
#undef I8_ROW0
}
__device__ __forceinline__ void quant_wqk(Frame& F, const bf16_t* WQK, unsigned char* WQ8, const unsigned* cmax) {
    int tid_ = tid_now(F.wave); asm volatile("" : "+v"(tid_)); const int lane_ = tid_ & 63;
    for (int rrow = F.gw; rrow < 2048; rrow += F.NGW) { const int L = rrow >> 10, n = rrow & 1023;
        const unsigned cm = cmax[rrow]; const float inv = cm ? 127.0f / __uint_as_float(cm) : 0.f;
        const u32x4* src = (const u32x4*)(WQK + (size_t)n * 4096 + L * 2048) + lane_;
        u32x2* dst = (u32x2*)(WQ8 + (size_t)rrow * 2048) + lane_;
#pragma unroll
        for (int j = 0; j < 4; ++j) { const u32x4 v = src[64 * j];
            u32x2 o; o.x = pk4_i8((f32x4){bf_lo(v.x), bf_hi(v.x), bf_lo(v.y), bf_hi(v.y)}, inv); o.y = pk4_i8((f32x4){bf_lo(v.z), bf_hi(v.z), bf_lo(v.w), bf_hi(v.w)}, inv);
            dst[64 * j] = o; } }
}
template <bool H16>
__device__ __forceinline__ void rms_row_i8(const void* xrow, const float* gain, unsigned char* orow, float* rs_row, int lane) {
    f32x4 v[8]; float s = 0.f;
#pragma unroll
    for (int j = 0; j < 8; ++j) { if constexpr (H16) v[j] = h4_to_f32(((const u32x2*)xrow + lane)[64 * j]); else v[j] = ((const f32x4*)xrow + lane)[64 * j]; s += (v[j][0] * v[j][0] + v[j][1] * v[j][1]) + (v[j][2] * v[j][2] + v[j][3] * v[j][3]); }
    const float rstd = 1.0f / sqrtf(wave_sum(s) * (1.0f / 2048.0f) + RMS_EPS);
    const f32x4* gr = (const f32x4*)gain + lane; float am = 0.f;
#pragma unroll
    for (int j = 0; j < 8; ++j) { v[j] = v[j] * rstd * gr[64 * j]; am = fmaxf(am, fmaxf(fmaxf(fabsf(v[j][0]), fabsf(v[j][1])), fmaxf(fabsf(v[j][2]), fabsf(v[j][3])))); }
    am = wave_max(am); const float inv = am > 0.f ? 127.0f / am : 0.f;
#pragma unroll
    for (int j = 0; j < 8; ++j) ((unsigned*)orow + lane)[64 * j] = pk4_i8(v[j], inv);
    if (lane == 0) *rs_row = am * (1.0f / 127.0f);
}
template <bool H16>
__device__ __forceinline__ void norm_phase_i8(Frame& F, const void* h, const float* gain, unsigned char* out, float* rs) {
    int tid_ = tid_now(F.wave); asm volatile("" : "+v"(tid_)); const int lane_ = tid_ & 63;
    for (int m = F.gw; m < T; m += F.NGW) rms_row_i8<H16>((const unsigned char*)h + (size_t)m * D * (H16 ? 2 : 4), gain, out + (size_t)m * D, rs + m, lane_);
}
__device__ __forceinline__ void moe_conv_slice(Frame& F, const float* wg, const float* wu, const float* wd, unsigned char* WGU, unsigned char* WD) {
    int tid_ = tid_now(F.wave); asm volatile("" : "+v"(tid_)); const int lane_ = tid_ & 63;
    LAS unsigned* scr = (LAS unsigned*)(F.lds + F.wave * 8448);
    constexpr int PER_E = 3 * 3584, TOTAL = NE * PER_E;
    int j0, j1;
    { const int b = (int)blockIdx.x, G = F.G; constexpr int LIGHT = 288;
      if (G > 8) { const int rest = TOTAL - 4 * LIGHT, q = rest / (G - 4), r = rest % (G - 4);
          if (b < 4) { j0 = b * LIGHT; j1 = j0 + LIGHT; } else { const int bb = b - 4; j0 = 4 * LIGHT + bb * q + (bb < r ? bb : r); j1 = j0 + q + (bb < r ? 1 : 0); } }
      else { const int q = TOTAL / G; j0 = b * q; j1 = (b == G - 1) ? TOTAL : j0 + q; } }
#define MC_DECODE(j_, W_, N_, k0_, n0_, dst_, ldd_) do { const int e_ = (j_) / PER_E, r_ = (j_) % PER_E, mat_ = r_ / 3584, rr_ = r_ % 3584; \
        if (mat_ < 2) { const int kb_ = rr_ / 112, nb_ = rr_ % 112; W_ = (mat_ ? wu : wg) + (size_t)e_ * 2048 * EDIM; N_ = EDIM; k0_ = kb_ * 64; n0_ = nb_ * 64; ldd_ = 2048; \
            dst_ = WGU + ((size_t)e_ * 2 * EDIM + (size_t)((n0_ >> 7) * 256 + (n0_ & 127) + mat_ * 128)) * 2048 + k0_; } \
        else { const int kb_ = rr_ / 32, nb_ = rr_ % 32; W_ = wd + (size_t)e_ * EDIM * 2048; N_ = 2048; k0_ = kb_ * 64; n0_ = nb_ * 64; ldd_ = EDIM; \
            dst_ = WD + ((size_t)e_ * 2048 + n0_) * EDIM + k0_; } } while (0)
    f32x4 a0[8], b0[8], a1[8], b1[8], a2[8], b2[8];
    const float* W0; const float* W1; const float* W2; int N0, N1, N2, k0, k1, k2, n0, n1, n2, l0, l1, l2; unsigned char* d0; unsigned char* d1; unsigned char* d2;
    int j = j0 + F.wave;
    if (j < j1) { MC_DECODE(j, W0, N0, k0, n0, d0, l0); t8_load(W0, N0, k0, n0, lane_, a0, b0); }
    if (j + 8 < j1) { MC_DECODE(j + 8, W1, N1, k1, n1, d1, l1); t8_load(W1, N1, k1, n1, lane_, a1, b1); }
    while (j < j1) {
        if (j + 16 < j1) { MC_DECODE(j + 16, W2, N2, k2, n2, d2, l2); t8_load(W2, N2, k2, n2, lane_, a2, b2); }
        t8_finish(a0, b0, d0, l0, 64.f, scr, lane_);
        if (j + 8 >= j1) break;
        if (j + 24 < j1) { MC_DECODE(j + 24, W0, N0, k0, n0, d0, l0); t8_load(W0, N0, k0, n0, lane_, a0, b0); }
        t8_finish(a1, b1, d1, l1, 64.f, scr, lane_);
        if (j + 16 >= j1) break;
        if (j + 32 < j1) { MC_DECODE(j + 32, W1, N1, k1, n1, d1, l1); t8_load(W1, N1, k1, n1, lane_, a1, b1); }
        t8_finish(a2, b2, d2, l2, 64.f, scr, lane_);
        j += 24;
    }
#undef MC_DECODE
    __syncthreads();
}
template <int OUT = 0  , bool H16 = false>
__device__ __forceinline__ void rms_row(const void* xrow, const float* gain, void* orow_, int lane, f32x4 (&v)[8]) {
    float s = 0.f;
#pragma unroll
    for (int j = 0; j < 8; ++j) { if constexpr (H16) v[j] = h4_to_f32(((const u32x2*)xrow + lane)[64 * j]); else v[j] = ((const f32x4*)xrow + lane)[64 * j]; s += (v[j][0] * v[j][0] + v[j][1] * v[j][1]) + (v[j][2] * v[j][2] + v[j][3] * v[j][3]); }
    const float rstd = 1.0f / sqrtf(wave_sum(s) * (1.0f / 2048.0f) + RMS_EPS);
    const f32x4* gr = (const f32x4*)gain + lane;
#pragma unroll
    for (int j = 0; j < 8; ++j) { const f32x4 g = gr[64 * j]; v[j] = v[j] * rstd * g;
        if constexpr (OUT == 0) { u32x2 w; w.x = cvt_pk_bf16(v[j][0], v[j][1]); w.y = cvt_pk_bf16(v[j][2], v[j][3]); ((u32x2*)orow_ + lane)[64 * j] = w; }
        else ((unsigned*)orow_ + lane)[64 * j] = pk4_fp8(v[j][0], v[j][1], v[j][2], v[j][3]); }
}
__device__ __forceinline__ void norm_phase(Frame& F, const float* h, const float* gain, bf16_t* out, int nrows) {
    int tid_ = tid_now(F.wave); asm volatile("" : "+v"(tid_)); const int lane_ = tid_ & 63;
    for (int m = F.gw; m < nrows; m += 2 * F.NGW) {
        const int m2 = m + F.NGW; const bool two = m2 < nrows;
        f32x4 v0[8], v1[8];
        const f32x4* x0 = (const f32x4*)(h + (size_t)m * D) + lane_; const f32x4* x1 = (const f32x4*)(h + (size_t)(two ? m2 : m) * D) + lane_;
#pragma unroll
        for (int j = 0; j < 8; ++j) v0[j] = x0[64 * j];
#pragma unroll
        for (int j = 0; j < 8; ++j) v1[j] = x1[64 * j];
        const f32x4* gr = (const f32x4*)gain + lane_;
        { float s = 0.f;
#pragma unroll
          for (int j = 0; j < 8; ++j) s += (v0[j][0] * v0[j][0] + v0[j][1] * v0[j][1]) + (v0[j][2] * v0[j][2] + v0[j][3] * v0[j][3]);
          const float rstd = 1.0f / sqrtf(wave_sum(s) * (1.0f / 2048.0f) + RMS_EPS); u32x2* o = (u32x2*)(out + (size_t)m * D) + lane_;
#pragma unroll
          for (int j = 0; j < 8; ++j) { const f32x4 r = v0[j] * rstd * gr[64 * j]; u32x2 w; w.x = cvt_pk_bf16(r[0], r[1]); w.y = cvt_pk_bf16(r[2], r[3]); o[64 * j] = w; } }
        if (two) { float s = 0.f;
#pragma unroll
          for (int j = 0; j < 8; ++j) s += (v1[j][0] * v1[j][0] + v1[j][1] * v1[j][1]) + (v1[j][2] * v1[j][2] + v1[j][3] * v1[j][3]);
          const float rstd = 1.0f / sqrtf(wave_sum(s) * (1.0f / 2048.0f) + RMS_EPS); u32x2* o = (u32x2*)(out + (size_t)m2 * D) + lane_;
#pragma unroll
          for (int j = 0; j < 8; ++j) { const f32x4 r = v1[j] * rstd * gr[64 * j]; u32x2 w; w.x = cvt_pk_bf16(r[0], r[1]); w.y = cvt_pk_bf16(r[2], r[3]); o[64 * j] = w; } }
    }
}
__device__ __forceinline__ void scan_phase(Frame& F, bf16_t* BS, const float* decay_logit) {
    int tid_ = tid_now(F.wave); asm volatile("" : "+v"(tid_)); const int lane_ = tid_ & 63;
    const int dir = lane_ >> 5;
    for (int w = F.gw; w < RH * RDV; w += F.NGW) {
        const int h = w >> 9, dv = w & 511;
        const float dch = __builtin_amdgcn_exp2f(log2_decay(decay_logit, dir, h) * 256.0f);
        bf16_t* p0 = BS + (((size_t)h * 64) * 512 + dv) * 768 + 256 + lane_ * 8;
        const size_t cstride = (size_t)512 * 768;
        float s[8];
#pragma unroll
        for (int e = 0; e < 8; ++e) s[e] = 0.f;
#pragma unroll 1
        for (int t0 = 0; t0 < 64; t0 += 8) {
            u32x4 v[8];
#pragma unroll
            for (int q = 0; q < 8; ++q) { const int i = dir ? 63 - (t0 + q) : (t0 + q); v[q] = *(const u32x4*)(p0 + (size_t)i * cstride); }
#pragma unroll
            for (int q = 0; q < 8; ++q) { const int i = dir ? 63 - (t0 + q) : (t0 + q);
                u32x4 o; o.x = cvt_pk_bf16(s[0], s[1]); o.y = cvt_pk_bf16(s[2], s[3]); o.z = cvt_pk_bf16(s[4], s[5]); o.w = cvt_pk_bf16(s[6], s[7]);
                *(u32x4*)(p0 + (size_t)i * cstride) = o;
                s[0] = dch * s[0] + bf_lo(v[q].x); s[1] = dch * s[1] + bf_hi(v[q].x); s[2] = dch * s[2] + bf_lo(v[q].y); s[3] = dch * s[3] + bf_hi(v[q].y);
                s[4] = dch * s[4] + bf_lo(v[q].z); s[5] = dch * s[5] + bf_hi(v[q].z); s[6] = dch * s[6] + bf_lo(v[q].w); s[7] = dch * s[7] + bf_hi(v[q].w); }
        }
    }
}
__device__ __forceinline__ void groupnorm_phase(Frame& F, const bf16_t* YRAW, bf16_t* GB, const float* gn_gain) {
    int tid_ = tid_now(F.wave); asm volatile("" : "+v"(tid_)); const int lane_ = tid_ & 63;
    const int h = F.gw & 7;
    const f32x4 g0 = *((const f32x4*)(gn_gain + h * 512) + 2 * lane_), g1 = *((const f32x4*)(gn_gain + h * 512) + 2 * lane_ + 1);
    const float gn[8] = {g0[0], g0[1], g0[2], g0[3], g1[0], g1[1], g1[2], g1[3]};
    for (int p0 = F.gw; p0 < T * RH; p0 += 4 * F.NGW) {
        u32x4 yv[4], gv[4];
#pragma unroll
        for (int q = 0; q < 4; ++q) { const int p = p0 + q * F.NGW; const int pc = p < T * RH ? p : p0; yv[q] = *((const u32x4*)(YRAW + (size_t)pc * 512) + lane_); gv[q] = *((const u32x4*)(GB + (size_t)pc * 512) + lane_); }
#pragma unroll
        for (int q = 0; q < 4; ++q) { const int p = p0 + q * F.NGW; if (p >= T * RH) break;
            float y[8] = {bf_lo(yv[q].x), bf_hi(yv[q].x), bf_lo(yv[q].y), bf_hi(yv[q].y), bf_lo(yv[q].z), bf_hi(yv[q].z), bf_lo(yv[q].w), bf_hi(yv[q].w)};
            float s = 0.f;
#pragma unroll
            for (int e = 0; e < 8; ++e) s += y[e];
            const float mu = wave_sum(s) * (1.0f / 512.0f); float qq = 0.f;
#pragma unroll
            for (int e = 0; e < 8; ++e) { y[e] -= mu; qq += y[e] * y[e]; }
            const float rstd = 1.0f / sqrtf(wave_sum(qq) * (1.0f / 512.0f) + GN_EPS);
            const float gg[8] = {bf_lo(gv[q].x), bf_hi(gv[q].x), bf_lo(gv[q].y), bf_hi(gv[q].y), bf_lo(gv[q].z), bf_hi(gv[q].z), bf_lo(gv[q].w), bf_hi(gv[q].w)};
#pragma unroll
            for (int e = 0; e < 8; ++e) y[e] = y[e] * rstd * gn[e] * gg[e];
            u32x4 o; o.x = cvt_pk_bf16(y[0], y[1]); o.y = cvt_pk_bf16(y[2], y[3]); o.z = cvt_pk_bf16(y[4], y[5]); o.w = cvt_pk_bf16(y[6], y[7]);
            *((u32x4*)(GB + (size_t)p * 512) + lane_) = o; }
    }
}
__device__ __forceinline__ void na_phase(Frame& F, const bf16_t* NQ, const bf16_t* NK, const bf16_t* NVT, bf16_t* NATT, const float* rpb) {
    int tid_ = tid_now(F.wave); asm volatile("" : "+v"(tid_)); const int lane_ = tid_ & 63;
    LAS float* rp = (LAS float*)F.lds;
    for (int i = tid_; i < NAH * 15 * 31; i += 512) rp[i] = rpb[i];
    __syncthreads();
    const int fr = lane_ & 15, fq = lane_ >> 4;
#define NA_LOADK(kf, batch) do { _Pragma("unroll") for (int bi = 0; bi < 4; ++bi) { const int b_ = (batch) * 4 + bi; \
        const bf16_t* kp_ = kbase + (size_t)((b_ >> 1) * 8 + (b_ & 1) * 2) * 1024; \
        _Pragma("unroll") for (int kk = 0; kk < 4; ++kk) kf[bi][kk] = *(const bf16x8*)(kp_ + kk * 256); } } while (0)
#define NA_MMAK(kf, batch) do { _Pragma("unroll") for (int bi = 0; bi < 4; ++bi) { f32x4 a_ = (f32x4){0.f, 0.f, 0.f, 0.f}; \
        _Pragma("unroll") for (int kk = 0; kk < 4; ++kk) a_ = __builtin_amdgcn_mfma_f32_16x16x32_bf16(kf[bi][kk], qf[kk], a_, 0, 0, 0); s[(batch) * 4 + bi] = a_; } } while (0)
#define NA_LOADV(vf, dd) do { const bf16_t* vr_ = vbase + (dd) * 64; \
        _Pragma("unroll") for (int bb = 0; bb < 8; ++bb) { const u32x2 lo_ = *(const u32x2*)(vr_ + bb * 8192), hi_ = *(const u32x2*)(vr_ + bb * 8192 + 2048); vf[bb] = (u32x4){lo_.x, lo_.y, hi_.x, hi_.y}; } } while (0)
#define NA_MMAV(vf, dd) do { f32x4 o_ = (f32x4){0.f, 0.f, 0.f, 0.f}; \
        _Pragma("unroll") for (int bb = 0; bb < 8; ++bb) o_ = __builtin_amdgcn_mfma_f32_16x16x32_bf16(__builtin_bit_cast(bf16x8, vf[bb]), pf[bb], o_, 0, 0, 0); \
        u32x2 w_; w_.x = cvt_pk_bf16(o_[0] * inv, o_[1] * inv); w_.y = cvt_pk_bf16(o_[2] * inv, o_[3] * inv); *(u32x2*)(obase + (dd) * 16) = w_; } while (0)
    for (int t = F.gw; t < T; t += F.NGW) {
        const int g = t & 3, h = (t >> 2) & 15, r = t >> 6;
        const int rs = min(max(r - 4, 0), 248);
        const int c0 = g == 0 ? 0 : (g == 1 ? 8 : (g == 2 ? 24 : 32));
        const int qc = 16 * g + fr, qtok = r * 64 + qc;
        const int cs = min(max(qc - 8, 0), 48);
        const bf16_t* kbase = NK + (size_t)h * T * 128 + ((size_t)(((rs * 64 + c0) >> 3) + (fr >> 3)) * 16 + fq) * 64 + (fr & 7) * 8;
        const bf16_t* vbase = NVT + (size_t)h * T * 128 + ((size_t)(((rs * 64 + c0) >> 2) + fq) * 128 + fr) * 4;
        bf16_t* obase = NATT + (size_t)qtok * 2048 + h * 128 + 4 * fq;
        bf16x8 qf[4];
#pragma unroll
        for (int kk = 0; kk < 4; ++kk) qf[kk] = *(const bf16x8*)(NQ + (size_t)qtok * 2048 + h * 128 + kk * 32 + fq * 8);
        f32x4 s[16];
        {
            bf16x8 kA[4][4], kB[4][4];
            NA_LOADK(kA, 0); NA_LOADK(kB, 1); __builtin_amdgcn_sched_barrier(0);
            NA_MMAK(kA, 0); __builtin_amdgcn_sched_barrier(0);
            NA_LOADK(kA, 2); __builtin_amdgcn_sched_barrier(0);
            NA_MMAK(kB, 1); __builtin_amdgcn_sched_barrier(0);
            NA_LOADK(kB, 3); __builtin_amdgcn_sched_barrier(0);
            NA_MMAK(kA, 2); __builtin_amdgcn_sched_barrier(0);
            NA_MMAK(kB, 3);
        }
        u32x4 vA[8], vB[8];
        NA_LOADV(vA, 0); NA_LOADV(vB, 1);
        float mx = -3.0e38f;
#pragma unroll
        for (int b = 0; b < 16; ++b) { const int dr = rs + (b >> 1) - r;
#pragma unroll
            for (int e = 0; e < 4; ++e) { const int kc = c0 + (b & 1) * 16 + 4 * fq + e; const bool ok = (kc >= cs) && (kc < cs + 16);
                const int dc = ok ? kc - qc : 0;
                const float bias = rp[h * 465 + (dr + 7) * 31 + dc + 15];
                const float v = ok ? s[b][e] + bias : -3.0e38f; s[b][e] = v; mx = fmaxf(mx, v); } }
        mx = fmaxf(mx, __shfl_xor(mx, 16)); mx = fmaxf(mx, __shfl_xor(mx, 32));
        float sum = 0.f;
#pragma unroll
        for (int b = 0; b < 16; ++b)
#pragma unroll
            for (int e = 0; e < 4; ++e) { const float q = s[b][e] > -1.0e38f ? fast_exp(s[b][e] - mx) : 0.f; s[b][e] = q; sum += q; }
        sum += __shfl_xor(sum, 16); sum += __shfl_xor(sum, 32);
        const float inv = __builtin_amdgcn_rcpf(sum);
        bf16x8 pf[8];
#pragma unroll
        for (int bb = 0; bb < 8; ++bb) { u32x4 w; w.x = cvt_pk_bf16(s[2 * bb][0], s[2 * bb][1]); w.y = cvt_pk_bf16(s[2 * bb][2], s[2 * bb][3]);
            w.z = cvt_pk_bf16(s[2 * bb + 1][0], s[2 * bb + 1][1]); w.w = cvt_pk_bf16(s[2 * bb + 1][2], s[2 * bb + 1][3]); pf[bb] = __builtin_bit_cast(bf16x8, w); }
        __builtin_amdgcn_sched_barrier(0);
        NA_MMAV(vA, 0); __builtin_amdgcn_sched_barrier(0); NA_LOADV(vA, 2); __builtin_amdgcn_sched_barrier(0);
        NA_MMAV(vB, 1); __builtin_amdgcn_sched_barrier(0); NA_LOADV(vB, 3); __builtin_amdgcn_sched_barrier(0);
        NA_MMAV(vA, 2); __builtin_amdgcn_sched_barrier(0); NA_LOADV(vA, 4); __builtin_amdgcn_sched_barrier(0);
        NA_MMAV(vB, 3); __builtin_amdgcn_sched_barrier(0); NA_LOADV(vB, 5); __builtin_amdgcn_sched_barrier(0);
        NA_MMAV(vA, 4); __builtin_amdgcn_sched_barrier(0); NA_LOADV(vA, 6); __builtin_amdgcn_sched_barrier(0);
        NA_MMAV(vB, 5); __builtin_amdgcn_sched_barrier(0); NA_LOADV(vB, 7); __builtin_amdgcn_sched_barrier(0);
        NA_MMAV(vA, 6); __builtin_amdgcn_sched_barrier(0);
        NA_MMAV(vB, 7);
    }
#undef NA_LOADK
#undef NA_MMAK
#undef NA_LOADV
#undef NA_MMAV
    __syncthreads();
}
__device__ __forceinline__ void moe_tile_starts(Frame& F, const unsigned* ctl, volatile LAS unsigned* ts) {
    int tid_ = tid_now(F.wave); asm volatile("" : "+v"(tid_)); const int lane_ = tid_ & 63;
    if (tid_ == 0) { unsigned a = 0; for (int e = 0; e < 8; ++e) { ts[e] = a; a += (ctl[CW_CNT + e] + 255u) >> 8; } ts[8] = a; }
    __syncthreads();
}
__device__ __forceinline__ void router_phase(Frame& F, unsigned* ctl, const h16_t* h, const float* gain, const float* wrouter, unsigned char* HN8, int* list_tok, unsigned* tokinfo) {
    int tid_ = tid_now(F.wave); asm volatile("" : "+v"(tid_)); const int lane_ = tid_ & 63;
    LAS float* wl = (LAS float*)F.lds;
    LAS int* selE = (LAS int*)(F.lds + 65536); LAS float* selW = (LAS float*)(F.lds + 65536 + 512); LAS int* rank = (LAS int*)(F.lds + 65536 + 1024); LAS int* base = (LAS int*)(F.lds + 65536 + 1536);
    for (int i = tid_; i < 2048 * 8; i += 512) { const int k = i >> 3, e = i & 7; wl[e * 2048 + k] = wrouter[i]; }
    __syncthreads();
    for (int rb = blockIdx.x; rb < T / 64; rb += F.G) {
#pragma unroll 1
        for (int q = 0; q < 8; ++q) {
            const int lr = F.wave * 8 + q, tok = rb * 64 + lr;
            f32x4 v[8]; rms_row<1, true>(h + (size_t)tok * D, gain, HN8 + (size_t)tok * D, lane_, v);
            float lg[8];
#pragma unroll
            for (int e = 0; e < 8; ++e) { float a = 0.f;
#pragma unroll
                for (int j = 0; j < 8; ++j) { const f32x4 w = *((const LAS f32x4*)(wl + e * 2048) + 64 * j + lane_); a += (v[j][0] * w[0] + v[j][1] * w[1]) + (v[j][2] * w[2] + v[j][3] * w[3]); }
                lg[e] = wave_sum(a); }
            int e1 = 0; float v1 = lg[0];
#pragma unroll
            for (int e = 1; e < 8; ++e) if (lg[e] > v1) { v1 = lg[e]; e1 = e; }
            int e2 = -1; float v2 = -3.0e38f;
#pragma unroll
            for (int e = 0; e < 8; ++e) if (e != e1 && lg[e] > v2) { v2 = lg[e]; e2 = e; }
            const float ex = expf(v2 - v1); const float w1 = 1.0f / (1.0f + ex), w2 = ex / (1.0f + ex);
            if (lane_ == 0) { selE[lr * 2] = e1; selE[lr * 2 + 1] = e2; selW[lr * 2] = w1; selW[lr * 2 + 1] = w2; }
        }
        __syncthreads();
        if (tid_ < 8) { int c = 0; for (int a = 0; a < 128; ++a) if (selE[a] == tid_) { rank[a] = c; ++c; }
            base[tid_] = c ? (int)atomicAdd(ctl + CW_CNT + tid_, (unsigned)c) : 0; }
        __syncthreads();
        if (tid_ < 128) { const int a = tid_, e = selE[a], pos = base[e] + rank[a], tok = rb * 64 + (a >> 1);
            list_tok[e * T + pos] = tok; tokinfo[tok * 4 + (a & 1)] = (unsigned)(e * T + pos); tokinfo[tok * 4 + 2 + (a & 1)] = __float_as_uint(selW[a]); }
        __syncthreads();
    }
}
__device__ __forceinline__ void gather_phase(Frame& F, const unsigned* ctl, const unsigned char* HN, const int* list_tok, unsigned char* XG, volatile LAS unsigned* ts) {
    int tid_ = tid_now(F.wave); asm volatile("" : "+v"(tid_)); const int lane_ = tid_ & 63;
    const int nrows = (int)ts[8] * 256;
    int tsv[8], cnt[8];
#pragma unroll
    for (int j = 0; j < 8; ++j) { tsv[j] = (int)ts[j]; cnt[j] = (int)ctl[CW_CNT + j]; }
    for (int s0 = F.gw * 16; s0 < nrows; s0 += F.NGW * 16) {
        const int rt = s0 >> 8; int e = 0, tbase = 0, ce = cnt[0];
#pragma unroll
        for (int j = 1; j < 8; ++j) if (tsv[j] <= rt) { e = j; tbase = tsv[j]; ce = cnt[j]; }
        const int pos = s0 + (lane_ & 15) - tbase * 256;
        const int tok = pos < ce ? list_tok[e * T + pos] : -1;
        u32x4 va[16], vb[16];
#pragma unroll
        for (int r = 0; r < 16; ++r) { const int tr = __builtin_amdgcn_readlane(tok, r); const u32x4* src = (const u32x4*)(HN + (size_t)(tr < 0 ? 0 : tr) * D) + lane_;
            va[r] = src[0]; vb[r] = src[64]; if (tr < 0) { va[r] = (u32x4){0u, 0u, 0u, 0u}; vb[r] = (u32x4){0u, 0u, 0u, 0u}; } }
#pragma unroll
        for (int r = 0; r < 16; ++r) { u32x4* dst = (u32x4*)(XG + (size_t)(s0 + r) * D) + lane_; dst[0] = va[r]; dst[64] = vb[r]; }
    }
}
__device__ __forceinline__ void add_expert_row(const bf16_t* Y, const bf16_t* YP, int slot, int tail_row0, float w, int lane, f32x4 (&v)[8]) {
    if (slot < tail_row0) { const u32x2* y = (const u32x2*)(Y + (size_t)slot * D) + lane; u32x2 a[8];
#pragma unroll
        for (int j = 0; j < 8; ++j) a[j] = y[64 * j];
#pragma unroll
        for (int j = 0; j < 8; ++j) { v[j][0] += w * bf_lo(a[j].x); v[j][1] += w * bf_hi(a[j].x); v[j][2] += w * bf_lo(a[j].y); v[j][3] += w * bf_hi(a[j].y); } }
    else {
#pragma unroll 1
        for (int q = 0; q < 4; ++q) { const u32x2* y = (const u32x2*)(YP + ((size_t)q * 2048 + (size_t)(slot - tail_row0)) * D) + lane; u32x2 a[8];
#pragma unroll
            for (int j = 0; j < 8; ++j) a[j] = y[64 * j];
#pragma unroll
            for (int j = 0; j < 8; ++j) { v[j][0] += w * bf_lo(a[j].x); v[j][1] += w * bf_hi(a[j].x); v[j][2] += w * bf_lo(a[j].y); v[j][3] += w * bf_hi(a[j].y); } } }
}
__device__ __forceinline__ void final_phase(Frame& F, const h16_t* hin, float* hout, const bf16_t* Y, const bf16_t* YP, const int tail_row0, const unsigned* tokinfo, const float* gain, volatile LAS unsigned* ts) {
    int tid_ = tid_now(F.wave); asm volatile("" : "+v"(tid_)); const int lane_ = tid_ & 63;
    int tsv[8];
#pragma unroll
    for (int j = 0; j < 8; ++j) tsv[j] = (int)ts[j];
#define FIN_TS(e_) ((e_) == 0 ? tsv[0] : (e_) == 1 ? tsv[1] : (e_) == 2 ? tsv[2] : (e_) == 3 ? tsv[3] : (e_) == 4 ? tsv[4] : (e_) == 5 ? tsv[5] : (e_) == 6 ? tsv[6] : tsv[7])
    const f32x4* gr = (const f32x4*)gain + lane_;
    for (int tok0 = F.gw; tok0 < T; tok0 += 2 * F.NGW) {
        const int tok1 = tok0 + F.NGW < T ? tok0 + F.NGW : tok0;
        const u32x4 i0 = *(const u32x4*)(tokinfo + tok0 * 4), i1 = *(const u32x4*)(tokinfo + tok1 * 4);
        const int sa0 = FIN_TS((int)(i0.x >> 14)) * 256 + (int)(i0.x & 16383), sb0 = FIN_TS((int)(i0.y >> 14)) * 256 + (int)(i0.y & 16383);
        const int sa1 = FIN_TS((int)(i1.x >> 14)) * 256 + (int)(i1.x & 16383), sb1 = FIN_TS((int)(i1.y >> 14)) * 256 + (int)(i1.y & 16383);
        const float wa0 = __uint_as_float(i0.z), wb0 = __uint_as_float(i0.w), wa1 = __uint_as_float(i1.z), wb1 = __uint_as_float(i1.w);
        f32x4* h0 = (f32x4*)(hout + (size_t)tok0 * D) + lane_; f32x4* h1 = (f32x4*)(hout + (size_t)tok1 * D) + lane_;
        const u32x2* g0 = (const u32x2*)(hin + (size_t)tok0 * D) + lane_; const u32x2* g1 = (const u32x2*)(hin + (size_t)tok1 * D) + lane_;
        f32x4 v0[8], v1[8];
        const int smax = max(max(sa0, sb0), max(sa1, sb1));
        if (__builtin_amdgcn_readfirstlane(smax) < tail_row0) {
            const u32x2* ya0 = (const u32x2*)(Y + (size_t)sa0 * D) + lane_; const u32x2* yb0 = (const u32x2*)(Y + (size_t)sb0 * D) + lane_;
            const u32x2* ya1 = (const u32x2*)(Y + (size_t)sa1 * D) + lane_; const u32x2* yb1 = (const u32x2*)(Y + (size_t)sb1 * D) + lane_;
            u32x2 a0[8], b0[8], a1[8], b1[8];
#pragma unroll
            for (int j = 0; j < 8; ++j) { v0[j] = h4_to_f32(g0[64 * j]); a0[j] = ya0[64 * j]; b0[j] = yb0[64 * j]; }
#pragma unroll
            for (int j = 0; j < 8; ++j) { v1[j] = h4_to_f32(g1[64 * j]); a1[j] = ya1[64 * j]; b1[j] = yb1[64 * j]; }
#pragma unroll
            for (int j = 0; j < 8; ++j) { v0[j][0] += wa0 * bf_lo(a0[j].x) + wb0 * bf_lo(b0[j].x); v0[j][1] += wa0 * bf_hi(a0[j].x) + wb0 * bf_hi(b0[j].x); v0[j][2] += wa0 * bf_lo(a0[j].y) + wb0 * bf_lo(b0[j].y); v0[j][3] += wa0 * bf_hi(a0[j].y) + wb0 * bf_hi(b0[j].y);
                v1[j][0] += wa1 * bf_lo(a1[j].x) + wb1 * bf_lo(b1[j].x); v1[j][1] += wa1 * bf_hi(a1[j].x) + wb1 * bf_hi(b1[j].x); v1[j][2] += wa1 * bf_lo(a1[j].y) + wb1 * bf_lo(b1[j].y); v1[j][3] += wa1 * bf_hi(a1[j].y) + wb1 * bf_hi(b1[j].y); }
        } else {
#pragma unroll
            for (int j = 0; j < 8; ++j) { v0[j] = h4_to_f32(g0[64 * j]); v1[j] = h4_to_f32(g1[64 * j]); }
            add_expert_row(Y, YP, sa0, tail_row0, wa0, lane_, v0); add_expert_row(Y, YP, sb0, tail_row0, wb0, lane_, v0);
            add_expert_row(Y, YP, sa1, tail_row0, wa1, lane_, v1); add_expert_row(Y, YP, sb1, tail_row0, wb1, lane_, v1);
        }
        { float s = 0.f;
#pragma unroll
          for (int j = 0; j < 8; ++j) s += (v0[j][0] * v0[j][0] + v0[j][1] * v0[j][1]) + (v0[j][2] * v0[j][2] + v0[j][3] * v0[j][3]);
          const float rstd = 1.0f / sqrtf(wave_sum(s) * (1.0f / 2048.0f) + RMS_EPS);
#pragma unroll
          for (int j = 0; j < 8; ++j) h0[64 * j] = v0[j] * rstd * gr[64 * j]; }
        if (tok1 != tok0) { float s = 0.f;
#pragma unroll
          for (int j = 0; j < 8; ++j) s += (v1[j][0] * v1[j][0] + v1[j][1] * v1[j][1]) + (v1[j][2] * v1[j][2] + v1[j][3] * v1[j][3]);
          const float rstd = 1.0f / sqrtf(wave_sum(s) * (1.0f / 2048.0f) + RMS_EPS);
#pragma unroll
          for (int j = 0; j < 8; ++j) h1[64 * j] = v1[j] * rstd * gr[64 * j]; }
    }
#undef FIN_TS
}

__device__ __forceinline__ const void* karg(int byte_off) {
    unsigned long long p; asm volatile("s_load_dwordx2 %0, %1, %2\n\ts_waitcnt lgkmcnt(0)" : "=s"(p) : "s"(__builtin_amdgcn_kernarg_segment_ptr()), "n"(byte_off) : "memory");
    return (const void*)(__attribute__((address_space(1))) const char*)p; }
#define INP(k) ((const float*)karg((k) * 8))
#define OUTP() ((float*)karg(176))
#define WSB() ((unsigned char*)karg(184))
#define WP(off) ((bf16_t*)(ws + (off)))

__global__ void __launch_bounds__(512, 2) fwd_kernel(Args args) {
    extern __shared__ __attribute__((aligned(16))) unsigned char lds_raw[];
    Frame F;
    F.lds = (LAS unsigned char*)lds_raw; F.MISC = (volatile LAS unsigned*)(F.lds + MISC_OFF);
    F.wave = __builtin_amdgcn_readfirstlane((int)threadIdx.x >> 6);
    F.G = gridDim.x; F.gw = blockIdx.x * 8 + F.wave; F.NGW = F.G * 8;
    for (int u = threadIdx.x; u < (LDS_BYTES - MISC_OFF) / 4; u += 512) ((LAS unsigned*)(F.lds + MISC_OFF))[u] = 0u;
    __syncthreads();
    XcdBarrier bar = xcd_barrier_post((unsigned*)(args.ws + WS_CTL) + CW_BAR, F.MISC + 8);
    volatile LAS unsigned* ts = F.MISC + 16;

    pg8::Order S;
    const int cblk = (int)blockIdx.x;
#define ORDER(nM, nN, rot) S.init((nM), (nN), F.G, (cblk + (rot)) % F.G)

    if (PH(0)) REPLOOP(0) {
        unsigned char* ws = WSB();
        i8_job<false>(F, INP(5), 2048, 12288, nullptr, 0, 0, 0, (unsigned*)(ws + CTL_CMAX_RET), 0);
        { CvPtrs P{INP(5), INP(6), INP(9), INP(10), INP(11), INP(12), INP(13), INP(20), INP(3), ws}; conv_all_p0(F, P); }
        i8_job<false>(F, INP(9), 2048, FFN, nullptr, 0, 1, 0, (unsigned*)(ws + CTL_CMAX_FFN), 0);
        i8_job<false>(F, INP(10), 2048, FFN, nullptr, 0, 1, 128, (unsigned*)(ws + CTL_CMAX_FFN), 768);
        i8_job<false>(F, INP(12), 2048, 6144, nullptr, 0, 0, 0, (unsigned*)(ws + CTL_CMAX_NA), 1536);
        { const float* xa_w_q = INP(19); bf16_t* W_XQ = WP(WS_W_XQ);
          for (int i = F.gw * 64 + (tid_now(F.wave) & 63); i < 2 * 2048 * 512 / 4; i += F.NGW * 64) { const f32x4 v = ((const f32x4*)xa_w_q)[i]; u32x2 w; w.x = cvt_pk_bf16(v[0], v[1]); w.y = cvt_pk_bf16(v[2], v[3]); ((u32x2*)W_XQ)[i] = w; } }
        { bf16_t* MEMK = WP(WS_MEMK);
          for (int i = F.gw * 64 + (tid_now(F.wave) & 63); i < 2 * 1024 * 512 * 2 / 16; i += F.NGW * 64) ((u32x4*)MEMK)[i] = (u32x4){0u, 0u, 0u, 0u}; }
        norm_phase_i8<false>(F, INP(0), INP(4) + 0 * D, ws + WS_HN, (float*)(ws + WS_RS));
        norm_phase(F, INP(1), INP(2), WP(WS_MEMN), NMEM);
    }
    xcd_barrier(bar, tid_now(F.wave) == 0);
    if (PH(26)) REPLOOP(26) { unsigned char* ws = WSB(); i8_job<true>(F, INP(5), 2048, 12288, ws + WS_W_RETIN, 2048, 0, 0, (unsigned*)(ws + CTL_CMAX_RET), 0); }
    xcd_barrier(bar, tid_now(F.wave) == 0);
    if (PH(1)) REPLOOP(1) {
        unsigned char* ws = WSB(); const float* decay_logit = INP(7);
        const unsigned char* HN8 = ws + WS_HN; const unsigned char* W8 = ws + WS_W_RETIN;
        const float* rs = (const float*)(ws + WS_RS); const unsigned* cmx = (const unsigned*)(ws + CTL_CMAX_RET);
        const int slot = (cblk >> 3) % 13;
#define CONV_SLICE() moe_conv_slice(F, INP(16), INP(17), INP(18), ws + WS_W_MOEGU, ws + WS_W_MOED)
#pragma unroll 1
        for (int seg = 0; seg < 2; ++seg) { const int cut = min(max(slot - 0, 0), 4);
            if (SB(0)) { ORDER(64, 16, 0); S.i0 = seg ? cut : 0; S.i1 = seg ? 4 : cut; MapAB8 mp{HN8, W8, (size_t)256 * 2048, (size_t)256 * 2048}; EpiRetQK8 E{WP(WS_QB), WP(WS_KB), WP(WS_AP), WP(WS_KZ), decay_logit, rs, cmx}; pg8::gemm_phase<3>(F.lds, F.wave, S, mp, 2048, 2048, 2048, E); }
            if (seg == 0 && slot >= 0 && slot < 4) CONV_SLICE(); }
#pragma unroll 1
        for (int seg = 0; seg < 2; ++seg) { const int cut = min(max(slot - 4, 0), 4);
            if (SB(1)) { ORDER(64, 16, 0); S.i0 = seg ? cut : 0; S.i1 = seg ? 4 : cut; MapAB8 mp{HN8, W8 + (size_t)8192 * 2048, (size_t)256 * 2048, (size_t)256 * 2048}; EpiSilu8i E{WP(WS_GB), rs, cmx + 8192}; pg8::gemm_phase<3>(F.lds, F.wave, S, mp, 2048, 2048, 2048, E); }
            if (seg == 0 && slot >= 4 && slot < 8) CONV_SLICE(); }
#pragma unroll 1
        for (int seg = 0; seg < 2; ++seg) { const int cut = min(max(slot - 8, 0), 4);
            if (SB(3)) { ORDER(16, 64, 0); S.i0 = seg ? cut : 0; S.i1 = seg ? 4 : cut; MapAB8 mp{W8 + (size_t)4096 * 2048, HN8, (size_t)256 * 2048, (size_t)256 * 2048}; EpiRetV8 E{WP(WS_BS), rs, cmx}; pg8::gemm_phase<3>(F.lds, F.wave, S, mp, 2048, 2048, 2048, E); }
            if (seg == 0 && slot >= 8 && slot < 12) CONV_SLICE(); }
        if (slot == 12) CONV_SLICE();
#undef CONV_SLICE
        if (SB(4)) { ORDER(1, 4, 0); MapAB mp{WP(WS_MEMN), WP(WS_W_MEMKV), 0, (size_t)256 * 2048}; EpiMemKV E{WP(WS_MEMK), WP(WS_MEMV)}; pg8::gemm_phase(F.lds, F.wave, S, mp, 2048, 2048, 2048, E); }
    }
    xcd_barrier(bar, tid_now(F.wave) == 0);
    if (PH(2)) REPLOOP(2) {
        unsigned char* ws = WSB(); const float* decay_logit = INP(7);
        if (SB(5)) { ORDER(512, 1, 0); MapRetS mp{WP(WS_QB), WP(WS_KB)}; EpiRetScores E{WP(WS_AP), decay_logit}; pg8::gemm_phase(F.lds, F.wave, S, mp, 256, 2048, 2048, E); }
        if (SB(6)) { ORDER(1024, 2, 0); MapRetKV mp{WP(WS_BS), WP(WS_KZ)}; EpiStore<AdRetKV> E{{WP(WS_BS)}}; pg8::gemm_phase(F.lds, F.wave, S, mp, 256, 768, T, E); }
        if (SB(7)) { ORDER(4, 16, 0); MapAB mp{WP(WS_MEMK), WP(WS_W_XQ), (size_t)256 * 512, (size_t)256 * 512}; EpiWqk E{WP(WS_W_QK), (unsigned*)(ws + CTL_CMAX_QK), 0.08838834764831845f}; pg8::gemm_phase(F.lds, F.wave, S, mp, 512, 512, 512, E); }
        if (SB(8)) { ORDER(16, 4, 64); MapAB mp{WP(WS_W_XOT), WP(WS_MEMV), (size_t)256 * 512, (size_t)256 * 512}; EpiStore<AdSimple> E{{WP(WS_W_VO), 1024, 1.f, 256}}; pg8::gemm_phase(F.lds, F.wave, S, mp, 512, 512, 512, E); }
    }
    xcd_barrier(bar, tid_now(F.wave) == 0);
    if (PH(3)) REPLOOP(3) { unsigned char* ws = WSB(); scan_phase(F, WP(WS_BS), INP(7));
        quant_wqk(F, WP(WS_W_QK), ws + WS_W_XQ, (const unsigned*)(ws + CTL_CMAX_QK));
        i8_job<true>(F, INP(12), 2048, 6144, ws + WS_W_NAIN, 2048, 0, 0, (unsigned*)(ws + CTL_CMAX_NA), 0);
        i8_job<true>(F, INP(9), 2048, FFN, ws + WS_W_FFNGU, 2048, 1, 0, (unsigned*)(ws + CTL_CMAX_FFN), 1024);
        i8_job<true>(F, INP(10), 2048, FFN, ws + WS_W_FFNGU, 2048, 1, 128, (unsigned*)(ws + CTL_CMAX_FFN), 1792); }
    xcd_barrier(bar, tid_now(F.wave) == 0);
    if (PH(4)) REPLOOP(4) { unsigned char* ws = WSB();
        if (SB(9)) { pg8::OrderPair SP; SP.init(512, F.G, cblk); MapRetO mp{WP(WS_AP), WP(WS_BS)}; EpiRetYGN E{WP(WS_YRAW), WP(WS_GB), INP(8), F.lds + EXCH_OFF, F.lds + MISC_OFF + 2048};
                     pg8::gemm_phase(F.lds, F.wave, SP, mp, 768, 768, 768, E); } }
    xcd_barrier(bar, tid_now(F.wave) == 0);
    if (PH(6)) REPLOOP(6) { unsigned char* ws = WSB();
        if (SB(10)) { ORDER(64, 8, 0); MapAB mp{WP(WS_GB), WP(WS_W_RETOUT), (size_t)256 * 4096, (size_t)256 * 4096}; EpiResidH<true> E{INP(0), (h16_t*)(ws + WS_H16)}; pg8::gemm_phase(F.lds, F.wave, S, mp, 4096, 4096, 4096, E); } }
    xcd_barrier(bar, tid_now(F.wave) == 0);
    if (PH(7)) REPLOOP(7) { unsigned char* ws = WSB(); norm_phase_i8<true>(F, ws + WS_H16, INP(4) + 1 * D, ws + WS_HN, (float*)(ws + WS_RS)); }
    xcd_barrier(bar, tid_now(F.wave) == 0);
    if (PH(8)) REPLOOP(8) { unsigned char* ws = WSB();
        if (SB(11)) { ORDER(64, 4, 0); MapAB8 mp{ws + WS_HN, ws + WS_W_XQ, (size_t)256 * 2048, (size_t)256 * 2048}; EpiXaSoftmax E{WP(WS_XP), F.lds + EXCH_OFF, (const float*)(ws + WS_RS), (const unsigned*)(ws + CTL_CMAX_QK)}; pg8::gemm_phase<3>(F.lds, F.wave, S, mp, 2048, 2048, 2048, E); } }
    xcd_barrier(bar, tid_now(F.wave) == 0);
    if (PH(9)) REPLOOP(9) { unsigned char* ws = WSB(); h16_t* hbuf = (h16_t*)(ws + WS_H16);
        if (SB(12)) { ORDER(64, 8, 0); MapAB mp{WP(WS_XP), WP(WS_W_VO), (size_t)256 * 1024, (size_t)256 * 1024}; EpiResidH<false> E{hbuf, hbuf}; pg8::gemm_phase(F.lds, F.wave, S, mp, 1024, 1024, 1024, E); } }
    xcd_barrier(bar, tid_now(F.wave) == 0);
    if (PH(10)) REPLOOP(10) { unsigned char* ws = WSB(); norm_phase_i8<true>(F, ws + WS_H16, INP(4) + 2 * D, ws + WS_HN, (float*)(ws + WS_RS)); }
    xcd_barrier(bar, tid_now(F.wave) == 0);
    if (PH(11)) REPLOOP(11) { unsigned char* ws = WSB();
        if (SB(13)) { ORDER(64, 44, 0); MapAB8 mp{ws + WS_HN, ws + WS_W_FFNGU, (size_t)256 * 2048, (size_t)256 * 2048}; EpiSwiglu8i E{WP(WS_FHID), FFN, (const float*)(ws + WS_RS), (const unsigned*)(ws + CTL_CMAX_FFN)}; pg8::gemm_phase<3>(F.lds, F.wave, S, mp, 2048, 2048, 2048, E); } }
    xcd_barrier(bar, tid_now(F.wave) == 0);
    if (PH(12)) REPLOOP(12) { unsigned char* ws = WSB(); h16_t* hbuf = (h16_t*)(ws + WS_H16);
        if (SB(14)) { ORDER(64, 8, 0); MapAB mp{WP(WS_FHID), WP(WS_W_FFND), (size_t)256 * FFN, (size_t)256 * FFN}; EpiResidH<false> E{hbuf, hbuf}; pg8::gemm_phase(F.lds, F.wave, S, mp, FFN, FFN, FFN, E); } }
    xcd_barrier(bar, tid_now(F.wave) == 0);
    if (PH(13)) REPLOOP(13) { unsigned char* ws = WSB(); norm_phase_i8<true>(F, ws + WS_H16, INP(4) + 3 * D, ws + WS_HN, (float*)(ws + WS_RS)); }
    xcd_barrier(bar, tid_now(F.wave) == 0);
    if (PH(14)) REPLOOP(14) { unsigned char* ws = WSB(); const unsigned char* HN8 = ws + WS_HN; const unsigned char* W8 = ws + WS_W_NAIN;
        const float* rs = (const float*)(ws + WS_RS); const unsigned* cmx = (const unsigned*)(ws + CTL_CMAX_NA);
        if (SB(15)) { ORDER(64, 16, 0); MapAB8 mp{HN8, W8, (size_t)256 * 2048, (size_t)256 * 2048}; EpiNaQK8 E{WP(WS_NQ), WP(WS_NK), rs, cmx}; pg8::gemm_phase<3>(F.lds, F.wave, S, mp, 2048, 2048, 2048, E); }
        if (SB(16)) { ORDER(8, 64, 0); MapAB8 mp{W8 + (size_t)4096 * 2048, HN8, (size_t)256 * 2048, (size_t)256 * 2048}; EpiNaV8 E{WP(WS_NVT), rs, cmx}; pg8::gemm_phase<3>(F.lds, F.wave, S, mp, 2048, 2048, 2048, E); }
    }
    xcd_barrier(bar, tid_now(F.wave) == 0);
    if (PH(15)) REPLOOP(15) { unsigned char* ws = WSB(); na_phase(F, WP(WS_NQ), WP(WS_NK), WP(WS_NVT), WP(WS_NATT), INP(14)); }
    xcd_barrier(bar, tid_now(F.wave) == 0);
    if (PH(16)) REPLOOP(16) { unsigned char* ws = WSB(); h16_t* hbuf = (h16_t*)(ws + WS_H16);
        if (SB(17)) { ORDER(64, 8, 0); MapAB mp{WP(WS_NATT), WP(WS_W_NAOUT), (size_t)256 * 2048, (size_t)256 * 2048}; EpiResidH<false> E{hbuf, hbuf}; pg8::gemm_phase(F.lds, F.wave, S, mp, 2048, 2048, 2048, E); } }
    xcd_barrier(bar, tid_now(F.wave) == 0);
    if (PH(17)) REPLOOP(17) { unsigned char* ws = WSB(); norm_phase_i8<true>(F, ws + WS_H16, INP(4) + 4 * D, ws + WS_HN, (float*)(ws + WS_RS)); }
    xcd_barrier(bar, tid_now(F.wave) == 0);
    if (PH(18)) REPLOOP(18) { unsigned char* ws = WSB();
        if (SB(18)) { ORDER(64, 4, 0); MapAB8 mp{ws + WS_HN, ws + WS_W_XQ + (size_t)1024 * 2048, (size_t)256 * 2048, (size_t)256 * 2048}; EpiXaSoftmax E{WP(WS_XP), F.lds + EXCH_OFF, (const float*)(ws + WS_RS), (const unsigned*)(ws + CTL_CMAX_QK) + 1024}; pg8::gemm_phase<3>(F.lds, F.wave, S, mp, 2048, 2048, 2048, E); } }
    xcd_barrier(bar, tid_now(F.wave) == 0);
    if (PH(19)) REPLOOP(19) { unsigned char* ws = WSB(); h16_t* hbuf = (h16_t*)(ws + WS_H16);
        if (SB(19)) { ORDER(64, 8, 0); MapAB mp{WP(WS_XP), WP(WS_W_VO) + (size_t)2048 * 1024, (size_t)256 * 1024, (size_t)256 * 1024}; EpiResidH<false> E{hbuf, hbuf}; pg8::gemm_phase(F.lds, F.wave, S, mp, 1024, 1024, 1024, E); } }
    xcd_barrier(bar, tid_now(F.wave) == 0);
    if (PH(20)) REPLOOP(20) { unsigned char* ws = WSB(); router_phase(F, (unsigned*)(ws + WS_CTL), (const h16_t*)(ws + WS_H16), INP(4) + 5 * D, INP(15), ws + WS_HN8, (int*)(ws + WS_LIST), (unsigned*)(ws + WS_TOKINFO)); }
    xcd_barrier(bar, tid_now(F.wave) == 0);
    if (PH(21)) REPLOOP(21) { unsigned char* ws = WSB(); moe_tile_starts(F, (unsigned*)(ws + WS_CTL), ts); gather_phase(F, (unsigned*)(ws + WS_CTL), ws + WS_HN8, (int*)(ws + WS_LIST), ws + WS_XG, ts); }
    xcd_barrier(bar, tid_now(F.wave) == 0);
    if (PH(22)) REPLOOP(22) { unsigned char* ws = WSB();
        if (SB(20)) { ORDER(__builtin_amdgcn_readfirstlane((int)ts[8]), 56, 0); MapMoe mp{ws + WS_XG, ws + WS_W_MOEGU, (size_t)256 * 2048, (size_t)2 * EDIM * 2048, (size_t)256 * 2048, ts}; EpiSwiglu8 E{ws + WS_MHID, EDIM}; pg8::gemm_phase<1>(F.lds, F.wave, S, mp, 2048, 2048, 2048, E); } }
    xcd_barrier(bar, tid_now(F.wave) == 0);
    if (PH(23)) REPLOOP(23) { unsigned char* ws = WSB();
        if (SB(21)) { pg8::OrderTail ST; ST.init(__builtin_amdgcn_readfirstlane((int)ts[8]), F.G, cblk); MapMoeD mp{ws + WS_MHID, ws + WS_W_MOED, ts}; EpiMoeDown E{WP(WS_XG), WP(WS_YP), ST.split ? (ST.tail_tile0() >> 3) * 256 : 0};
                      pg8::gemm_phase<1>(F.lds, F.wave, ST, mp, EDIM, EDIM, EDIM, E); } }
    xcd_barrier(bar, tid_now(F.wave) == 0);
    if (PH(24)) REPLOOP(24) { unsigned char* ws = WSB(); pg8::OrderTail ST; ST.init(__builtin_amdgcn_readfirstlane((int)ts[8]), F.G, cblk);
        final_phase(F, (const h16_t*)(ws + WS_H16), OUTP(), WP(WS_XG), WP(WS_YP), ST.split ? (ST.tail_tile0() >> 3) * 256 : 0x7fffffff, (unsigned*)(ws + WS_TOKINFO), INP(21), ts); }
#undef ORDER
}

extern "C" void kernel_launch(void* const* d_in, const int* in_sizes, int n_in, void* d_out, int out_size, void* d_ws, size_t ws_size, hipStream_t stream) {
    static int grid = 0;
    if (grid == 0) {
        if (n_in != 22 || out_size != T * D || ws_size < WS_END) { fprintf(stderr, "kernel_launch: unexpected shapes (n_in %d, out %d, ws %zu < %zu)\n", n_in, out_size, ws_size, (size_t)WS_END); grid = -1; return; }
        int dev = 0, cus = 0, per_cu = 0;
        if (hipGetDevice(&dev) != hipSuccess || hipDeviceGetAttribute(&cus, hipDeviceAttributeMultiprocessorCount, dev) != hipSuccess) { grid = -1; return; }
        if (hipFuncSetAttribute((const void*)fwd_kernel, hipFuncAttributeMaxDynamicSharedMemorySize, LDS_BYTES) != hipSuccess) { fprintf(stderr, "kernel_launch: hipFuncSetAttribute failed\n"); grid = -1; return; }
        if (hipOccupancyMaxActiveBlocksPerMultiprocessor(&per_cu, (const void*)fwd_kernel, 512, LDS_BYTES) != hipSuccess || per_cu < 1) { fprintf(stderr, "kernel_launch: occupancy query says %d blocks per CU\n", per_cu); }
        (void)hipGetLastError();
        grid = cus;
    }
    if (grid < 0) return;
    (void)in_sizes;
    if (hipMemsetAsync((char*)d_ws + WS_CTL, 0, CTL_ZERO_BYTES, stream) != hipSuccess) return;
    Args a{};
    for (int i = 0; i < 22; ++i) a.in[i] = (const float*)d_in[i];
    a.out = (float*)d_out; a.ws = (unsigned char*)d_ws;
    hipLaunchKernelGGL(fwd_kernel, dim3(grid), dim3(512), LDS_BYTES, stream, a);
}
```

```cpp
#include <hip/hip_runtime.h>
#include <cstdio>
#include <cstdint>

#ifndef ONLY
#define ONLY -1
#endif
#ifndef PLO
#define PLO 0
#endif
#ifndef PHI
#define PHI 99
#endif
#define PH(n) ((ONLY < 0 || ONLY == (n)) && (n) >= PLO && (n) <= PHI)
#ifndef DBLMASK
#define DBLMASK 0u
#endif
#define NREP(k) ((((unsigned)(DBLMASK)) >> (k)) & 1u ? 2 : 1)
#if DBLMASK
#define REPLOOP(k) for (int rep_ = 0; rep_ < NREP(k); ++rep_)
#else
#define REPLOOP(k)
#endif
#ifndef SUB
#define SUB -1
#endif
#define SB(j) (SUB < 0 || SUB == (j))
#define LAS __attribute__((address_space(3)))
typedef unsigned short bf16_t;
typedef short bf16x8 __attribute__((ext_vector_type(8)));
typedef float f32x4 __attribute__((ext_vector_type(4)));
typedef float f32x2 __attribute__((ext_vector_type(2)));
typedef unsigned u32x4 __attribute__((ext_vector_type(4)));
typedef unsigned u32x2 __attribute__((ext_vector_type(2)));

constexpr int T = 16384, D = 2048, NMEM = 256;
constexpr int RH = 8, RDK = 256, RDV = 512, RC = 256, RNC = T / RC;
constexpr int FFN = 5632, NE = 8, EDIM = 7168;
constexpr int NAH = 16;
constexpr int MOE_ROWS_MAX = 34816;
constexpr float RMS_EPS = 1e-6f, GN_EPS = 1e-6f;

constexpr size_t MiB = 1u << 20;
constexpr size_t WS_CTL = 0, CTL_ZERO_BYTES = 196608;
constexpr size_t CTL_CMAX_FFN = 65536, CTL_CMAX_NA = 65536 + 45056, CTL_CMAX_RET = 65536 + 45056 + 24576, CTL_CMAX_QK = 65536 + 45056 + 24576 + 49152;
constexpr size_t WS_W_RETIN = 1 * MiB, WS_W_RETOUT = 49 * MiB, WS_W_FFNGU = 65 * MiB, WS_W_FFND = 109 * MiB, WS_W_NAIN = 131 * MiB, WS_W_NAOUT = 155 * MiB;
constexpr size_t WS_W_XQ = 163 * MiB, WS_W_XOT = 167 * MiB, WS_W_MEMKV = 171 * MiB, WS_W_QK = 175 * MiB, WS_W_VO = 183 * MiB;
constexpr size_t WS_MEMK = 191 * MiB, WS_MEMV = 192 * MiB, WS_MEMN = 193 * MiB, WS_LIST = 194 * MiB, WS_TOKINFO = 194 * MiB + 512 * 1024;
constexpr size_t WS_RS = 194 * MiB + 768 * 1024;
constexpr size_t WS_HN = 196 * MiB;
constexpr size_t WS_BS = 260 * MiB, WS_AP = 644 * MiB;
constexpr size_t WS_X = 836 * MiB;
constexpr size_t WS_W_MOEGU = 1380 * MiB, WS_W_MOED = 1604 * MiB;
constexpr size_t WS_HN8 = WS_X + 376 * MiB;
constexpr size_t WS_QB = WS_X, WS_KB = WS_X + 64 * MiB, WS_KZ = WS_X + 128 * MiB, WS_GB = WS_X + 256 * MiB, WS_YRAW = WS_X + 384 * MiB;
constexpr size_t WS_XP = WS_X + 512 * MiB;
constexpr size_t WS_FHID = WS_X;
constexpr size_t WS_NQ = WS_X, WS_NK = WS_X + 64 * MiB, WS_NVT = WS_X + 128 * MiB, WS_NATT = WS_X + 192 * MiB;
constexpr size_t WS_XG = WS_X, WS_MHID = WS_X + 136 * MiB;
constexpr size_t WS_H16 = WS_BS;
constexpr size_t WS_YP = 1716 * MiB;
constexpr size_t WS_END = 1748 * MiB;
constexpr int CW_BAR = 4096, CW_CNT = 8192;

constexpr int RING_BYTES = 131072, EXCH_OFF = RING_BYTES, EXCH_BYTES = 8192, MISC_OFF = EXCH_OFF + EXCH_BYTES, LDS_BYTES = 147456;

__device__ __forceinline__ unsigned cvt_pk_bf16(float lo, float hi) { unsigned r; asm volatile("v_cvt_pk_bf16_f32 %0, %1, %2" : "=v"(r) : "v"(lo), "v"(hi)); return r; }
__device__ __forceinline__ float bf_lo(unsigned w) { return __uint_as_float(w << 16); }
__device__ __forceinline__ float bf_hi(unsigned w) { return __uint_as_float(w & 0xffff0000u); }
__device__ __forceinline__ float wave_sum(float v) {
#pragma unroll
    for (int o = 1; o < 64; o <<= 1) v += __shfl_xor(v, o);
    return v;
}
__device__ __forceinline__ float fast_exp(float x) { return __builtin_amdgcn_exp2f(x * 1.44269504f); }
__device__ __forceinline__ float silu_f(float x) { return x * __builtin_amdgcn_rcpf(1.0f + fast_exp(-x)); }
__device__ __forceinline__ float log2_decay(const float* decay_logit, int dir, int h) {
    const float z = decay_logit[dir * RH + h];
    return -log1pf(expf(-z)) * 1.44269504f;
}
__device__ __forceinline__ int tid_now(int wave) { unsigned z; asm volatile("v_mov_b32 %0, 0" : "=v"(z)); return wave * 64 + (int)__builtin_amdgcn_mbcnt_hi(~0u, __builtin_amdgcn_mbcnt_lo(~0u, z)); }
#define LDS_WAIT() asm volatile("s_waitcnt lgkmcnt(0)" ::: "memory")
#define VM_WAIT() asm volatile("s_waitcnt vmcnt(0)" ::: "memory")

#define XB_TMO      128
#define XB_XCNT(j)  (256  + 64 * (j))
#define XB_XSUB(j)  (1280 + 64 * (j))
#define XB_XGEN(j)  (2304 + 64 * (j))
#define XB_TOP      3328
#define XB_TOPGEN   3392
#define XCD_BAR_WORDS 3456
#define XB_SPIN_CAP (1u << 18)

__device__ __forceinline__ unsigned xb_ld(unsigned* p)              { return __hip_atomic_load(p, __ATOMIC_RELAXED, __HIP_MEMORY_SCOPE_AGENT); }
__device__ __forceinline__ unsigned xb_add(unsigned* p, unsigned v) { return __hip_atomic_fetch_add(p, v, __ATOMIC_RELAXED, __HIP_MEMORY_SCOPE_AGENT); }
__device__ __forceinline__ unsigned xb_xcc_id() { return (unsigned)__builtin_amdgcn_s_getreg((3 << 11) | 20) & 0xFu; }
#define XB_SPIN(cond, bar) do { unsigned _sp = 0; while (cond) { __builtin_amdgcn_s_sleep(1); \
    if ((++_sp & 255u) == 0u) { if (xb_ld(&(bar)[XB_TMO])) break; if (_sp > XB_SPIN_CAP) { atomicAdd(&(bar)[XB_TMO], 1u); break; } } } } while (0)

struct XcdBarrier { unsigned* bar; unsigned x; volatile LAS unsigned* st; };

__device__ __forceinline__ XcdBarrier xcd_barrier_post(unsigned* bar, volatile LAS unsigned* st) {
    XcdBarrier b; b.bar = bar; b.x = xb_xcc_id(); b.st = st;
    if (threadIdx.x == 0) (void)xb_add(&bar[XB_XCNT(b.x)], 1u);
    return b;
}
__device__ __forceinline__ void xcd_barrier_complete(unsigned* bar, unsigned x, unsigned& nloc, unsigned& nx) {
    const unsigned G = gridDim.x * gridDim.y * gridDim.z;
    unsigned sum, cnt, mine, sp = 0u;
    for (;;) {
        sum = 0u; cnt = 0u; mine = 0u;
#pragma unroll
        for (unsigned j = 0; j < 16; ++j) { const unsigned c = xb_ld(&bar[XB_XCNT(j)]); sum += c; cnt += (c > 0u) ? 1u : 0u; mine = (j == x) ? c : mine; }
        if (sum == G) break;
        __builtin_amdgcn_s_sleep(1);
        if ((++sp & 255u) == 0u) { if (xb_ld(&bar[XB_TMO])) break; if (sp > XB_SPIN_CAP) { atomicAdd(&bar[XB_TMO], 1u); break; } }
    }
    nloc = mine > 0u ? mine : 1u; nx = cnt > 0u ? cnt : 1u;
}
__device__ __forceinline__ void xcd_barrier(const XcdBarrier& b, const bool t0  ) {
    asm volatile("s_waitcnt vmcnt(0)" ::: "memory");
    __syncthreads();
    if (t0) {
        unsigned* bar = b.bar; asm volatile("" : "+s"(bar));
        __builtin_amdgcn_s_waitcnt(0);
        unsigned nloc = b.st[0], nx = b.st[1];
        if (nloc == 0u) { xcd_barrier_complete(bar, b.x, nloc, nx); b.st[0] = nloc; b.st[1] = nx; }
        const unsigned old = xb_add(&bar[XB_XSUB(b.x)], 1u);
        const unsigned gen = old / nloc;
        if (old + 1u == (gen + 1u) * nloc) {
            __builtin_amdgcn_fence(__ATOMIC_RELEASE, "agent");
            asm volatile("s_waitcnt vmcnt(0)" ::: "memory");
            const unsigned og = xb_add(&bar[XB_TOP], 1u);
            const unsigned tg = og / nx;
            if (og + 1u == (tg + 1u) * nx) xb_add(&bar[XB_TOPGEN], 1u);
            else XB_SPIN(xb_ld(&bar[XB_TOPGEN]) == tg, bar);
            __builtin_amdgcn_fence(__ATOMIC_ACQUIRE, "agent");
            xb_add(&bar[XB_XGEN(b.x)], 1u);
            asm volatile("s_waitcnt vmcnt(0)" ::: "memory");
        } else {
            XB_SPIN(xb_ld(&bar[XB_XGEN(b.x)]) == gen, bar);
            __builtin_amdgcn_fence(__ATOMIC_ACQUIRE, "agent");
            asm volatile("s_waitcnt vmcnt(0)" ::: "memory");
        }
    }
    __syncthreads();
}

__device__ __forceinline__ const char* uni_ptr(const char* p) { const unsigned long long v = (unsigned long long)p; const unsigned lo = __builtin_amdgcn_readfirstlane((int)(unsigned)v), hi = __builtin_amdgcn_readfirstlane((int)(unsigned)(v >> 32));
    return (const char*)(((unsigned long long)hi << 32) | lo); }
typedef int v8i32 __attribute__((ext_vector_type(8)));
typedef int v4i32 __attribute__((ext_vector_type(4)));
__device__ __forceinline__ v8i32 pk8(bf16x8 lo, bf16x8 hi) { return __builtin_shufflevector(__builtin_bit_cast(v4i32, lo), __builtin_bit_cast(v4i32, hi), 0, 1, 2, 3, 4, 5, 6, 7); }
__device__ __forceinline__ unsigned pk4_fp8(float a, float b, float c, float d) { int r = __builtin_amdgcn_cvt_pk_fp8_f32(a, b, 0, false); r = __builtin_amdgcn_cvt_pk_fp8_f32(c, d, r, true); return (unsigned)r; }
__device__ __forceinline__ unsigned pk4_i8(f32x4 v, float inv) {
    const int a = (int)__builtin_rintf(v[0] * inv), b = (int)__builtin_rintf(v[1] * inv), c = (int)__builtin_rintf(v[2] * inv), d = (int)__builtin_rintf(v[3] * inv);
    return ((unsigned)a & 0xffu) | (((unsigned)b & 0xffu) << 8) | (((unsigned)c & 0xffu) << 16) | ((unsigned)d << 24); }
typedef _Float16 f16x4 __attribute__((ext_vector_type(4)));
typedef unsigned short h16_t;
__device__ __forceinline__ f32x4 h4_to_f32(u32x2 w) { return __builtin_convertvector(__builtin_bit_cast(f16x4, w), f32x4); }
__device__ __forceinline__ u32x2 f32_to_h4(f32x4 v) { return __builtin_bit_cast(u32x2, __builtin_convertvector(v, f16x4)); }
__device__ __forceinline__ float wave_max(float v) {
#pragma unroll
    for (int o = 1; o < 64; o <<= 1) v = fmaxf(v, __shfl_xor(v, o));
    return v;
}
namespace pg8 {
constexpr int BM = 256, BK = 64, HALF = 128, HTB = HALF * BK * 2, STAGE_BYTES = 8 * HTB, NXCD = 8, WGM = 4;
__host__ __device__ __forceinline__ int lds_byte(int r, int c) { const int st = (r >> 4) * 2 + (c >> 5), rr = r & 15, cc = c & 31, ob = rr * 64 + cc * 2; return st * 1024 + (ob ^ (((ob >> 9) & 1) << 5)); }
__host__ __device__ __forceinline__ void stage_rc(int b, int& R, int& C) { const int st = b / 1024, sb = b % 1024, swz = sb ^ (((sb >> 9) & 1) << 5); R = (st >> 1) * 16 + swz / 64; C = (st & 1) * 32 + (swz % 64) / 2; }
__host__ __device__ __forceinline__ int perm32(int rho) { const int n = rho >> 4, i = rho & 15; return 8 * (i >> 2) + 4 * n + (i & 3); }

struct Unit { int pm, pn, kq; };
struct Order {
    int nM, nN, nwg, G, c, i0, i1;
    __device__ __forceinline__ void init(int nM_, int nN_, int G_, int c_) { nM = nM_; nN = nN_; nwg = nM * nN; G = G_; c = c_; i0 = 0; i1 = 0x7fffffff; }
    __device__ __forceinline__ bool next(int i, Unit& u) const {
        const int ii = i + i0; if (ii >= i1) return false;
        const long L = (long)ii * G + c; if (L >= nwg) return false;
        int wgid = (int)L; { const int q = nwg / NXCD, r = nwg % NXCD, xcd = wgid % NXCD, off = wgid / NXCD; wgid = (xcd < r ? xcd * (q + 1) : r * (q + 1) + (xcd - r) * q) + off; }
        const int nig = WGM * nN, gid = wgid / nig, fm = gid * WGM, gsz = (nM - fm) < WGM ? (nM - fm) : WGM;
        u.pm = fm + ((wgid % nig) % gsz); u.pn = (wgid % nig) / gsz; u.kq = -1; return true;
    }
    __device__ __forceinline__ int unit_nt(const Unit&, int nt) const { return nt; }
};

struct OrderTail {
    int nwg, G, c, R, L; bool split;
    __device__ __forceinline__ void init(int nM, int G_, int c_) { nwg = nM * 8; G = G_; const int r = nwg / G_, l = nwg % G_; split = ((G_ & 7) == 0) && l > 0 && l <= 64; R = split ? r : (nwg + G_ - 1) / G_; L = split ? l : 0;
        c = ((G_ & 7) == 0) ? (c_ & 7) * (G_ >> 3) + (c_ >> 3) : c_; }
    __device__ __forceinline__ int tail_tile0() const { return split ? R * G : 0x7fffffff; }
    __device__ __forceinline__ bool next(int i, Unit& u) const {
        if (i < R) { const int idx = i * G + c; if (idx >= nwg) return false; u.pm = idx >> 3; u.pn = idx & 7; u.kq = -1; return true; }
        const int v = (i - R) * G + c; if (v >= 4 * L) return false;
        const int idx = R * G + (v >> 2); u.pm = idx >> 3; u.pn = idx & 7; u.kq = v & 3; return true;
    }
    __device__ __forceinline__ int unit_nt(const Unit& u, int nt) const { return u.kq < 0 ? nt : (nt >> 2); }
};

#ifndef ALIGN_ALL
#define ALIGN_ALL 1
#endif
template <int FMT = 2  , bool ALIGN = (ALIGN_ALL != 0), class Epi, class Map, class Sched>
__device__ __forceinline__ void gemm_phase(LAS unsigned char* lds, const int wave_, const Sched& S, const Map& MP, const int K, const int lda, const int ldb, const Epi& E) {
    int tid_ = tid_now(wave_); asm volatile("" : "+v"(tid_));
    const int tid = tid_, wid = __builtin_amdgcn_readfirstlane(tid >> 6), lane = tid & 63, wr = wid >> 2, wc = wid & 3, fr = lane & 15, fq = lane >> 4;
    constexpr int ESZ = (FMT == 2) ? 2 : 1;
    int nt = K * ESZ / (BK * 2);
    asm volatile("" : "+s"(nt));
    unsigned voffA[2], voffB[2];
#pragma unroll
    for (int i = 0; i < 2; ++i) { int R, C; stage_rc(tid * 16 + i * 8192, R, C); const int Rb = Epi::PERM ? ((R & ~31) + perm32(R & 31)) : R;
        voffA[i] = (unsigned)(R * lda * ESZ + C * 2); voffB[i] = (unsigned)(Rb * ldb * ESZ + C * 2); }
    const size_t kstep = (size_t)(BK * 2);
    const size_t hstepA = (size_t)HALF * lda * ESZ, hstepB = (size_t)HALF * ldb * ESZ;
    const unsigned ldsw = (unsigned)wid * 1024u;
    const unsigned ldsbase = (unsigned)__builtin_amdgcn_readfirstlane((int)(unsigned)(size_t)lds + (int)ldsw);
    const int aoff = lds_byte(wr * 64 + fr, fq * 8), boff = lds_byte(wc * 32 + fr, fq * 8);
#define PG8_SA(b, h) (((b) * 2 + (h)) * HTB)
#define PG8_SB(b, h) ((4 + (b) * 2 + (h)) * HTB)
#define PG8_STAGE(bufoff, gbase, voff) do { _Pragma("unroll") for (int _i = 0; _i < 2; ++_i) { unsigned keep_; \
        asm volatile("s_mov_b32 %0, m0\n\ts_add_u32 m0, %3, %4\n\ts_nop 0\n\tglobal_load_lds_dwordx4 %1, %2\n\ts_mov_b32 m0, %0" \
            : "=&s"(keep_) : "v"((voff)[_i]), "s"((const char*)(gbase)), "s"(ldsbase), "n"((bufoff) + _i * 8192) : "memory", "scc"); } } while (0)
#define PG8_LDA(dst, b, h) do { _Pragma("unroll") for (int m = 0; m < 4; ++m) { _Pragma("unroll") for (int k = 0; k < 2; ++k) dst[m][k] = *(const LAS bf16x8*)(lds + PG8_SA(b, h) + aoff + m * 2048 + k * 1024); \
        if constexpr (FMT == 1) dst##8[m] = pk8(dst[m][0], dst[m][1]); } } while (0)
#define PG8_LDB(dst, b, h) do { _Pragma("unroll") for (int n = 0; n < 2; ++n) { _Pragma("unroll") for (int k = 0; k < 2; ++k) dst[n][k] = *(const LAS bf16x8*)(lds + PG8_SB(b, h) + boff + n * 2048 + k * 1024); \
        if constexpr (FMT == 1) dst##8[n] = pk8(dst[n][0], dst[n][1]); } } while (0)
#define PG8_MMA(ai, bj, At, Bt) do { __builtin_amdgcn_s_setprio(1); _Pragma("unroll") for (int m = 0; m < 4; ++m) _Pragma("unroll") for (int n = 0; n < 2; ++n) { \
        if constexpr (FMT == 2) { _Pragma("unroll") for (int k = 0; k < 2; ++k) acc[ai][bj][m][n] = __builtin_amdgcn_mfma_f32_16x16x32_bf16(Bt[n][k], At[m][k], acc[ai][bj][m][n], 0, 0, 0); } \
        else if constexpr (FMT == 3) { _Pragma("unroll") for (int k = 0; k < 2; ++k) acc[ai][bj][m][n] = __builtin_bit_cast(f32x4, __builtin_amdgcn_mfma_i32_16x16x64_i8(__builtin_bit_cast(v4i32, Bt[n][k]), __builtin_bit_cast(v4i32, At[m][k]), __builtin_bit_cast(v4i32, acc[ai][bj][m][n]), 0, 0, 0)); } \
        else { acc[ai][bj][m][n] = __builtin_amdgcn_mfma_scale_f32_16x16x128_f8f6f4(Bt##8[n], At##8[m], acc[ai][bj][m][n], 0, 0, 0, 0x7f7f7f7f, 0, 0x7f7f7f7f); } } \
        __builtin_amdgcn_s_setprio(0); } while (0)
#define PG8_WAIT_V(n) asm volatile("s_waitcnt vmcnt(" #n ")" ::: "memory")
#define PG8_WAIT_L(n) asm volatile("s_waitcnt lgkmcnt(" #n ")" ::: "memory")
#define PG8_BAR __builtin_amdgcn_s_barrier()
#define PG8_SCHED __builtin_amdgcn_sched_barrier(0)
    Unit cur, nxt; int ui = 0;
    if (!S.next(0, cur)) return;
    f32x4 acc[2][2][4][2];
#pragma unroll
    for (int a = 0; a < 2; ++a)
#pragma unroll
        for (int b = 0; b < 2; ++b)
#pragma unroll
            for (int m = 0; m < 4; ++m)
#pragma unroll
                for (int n = 0; n < 2; ++n) acc[a][b][m][n] = (f32x4){0.f, 0.f, 0.f, 0.f};
    bf16x8 At[4][2], B0[2][2], B1[2][2]; v8i32 At8[4], B08[2], B18[2];
    const char* cA; const char* cB; MP(cur, cA, cB); cA = uni_ptr(cA); cB = uni_ptr(cB);
    PG8_STAGE(PG8_SB(0, 0), cB, voffB); PG8_STAGE(PG8_SB(0, 1), cB + hstepB, voffB); PG8_STAGE(PG8_SA(0, 0), cA, voffA); PG8_STAGE(PG8_SA(0, 1), cA + hstepA, voffA);
    if (wr == 1) PG8_BAR;
    PG8_WAIT_V(2); PG8_BAR;
    PG8_STAGE(PG8_SB(1, 0), cB + kstep, voffB); PG8_STAGE(PG8_SA(1, 0), cA + kstep, voffA); PG8_STAGE(PG8_SB(1, 1), cB + hstepB + kstep, voffB);
    PG8_WAIT_V(6); PG8_BAR;
    for (;;) {
        const bool has_next = S.next(ui + 1, nxt);
        const char* nA = cA; const char* nB = cB; if (has_next) { MP(nxt, nA, nB); nA = uni_ptr(nA); nB = uni_ptr(nB); }
        const int unt = S.unit_nt(cur, nt);
#pragma unroll 1
        for (int t = 0; t < unt; t += 2) {
            const bool last = (t == unt - 2);
            const char* a1 = cA + (size_t)(t + 1) * kstep;
            const char* a2 = last ? nA : cA + (size_t)(t + 2) * kstep; const char* b2 = last ? nB : cB + (size_t)(t + 2) * kstep;
            const char* a3 = a2 + kstep; const char* b3 = b2 + kstep;
            PG8_LDB(B0, 0, 0); PG8_LDB(B1, 0, 1); PG8_SCHED; PG8_LDA(At, 0, 0); PG8_STAGE(PG8_SA(1, 1), a1 + hstepA, voffA);
            PG8_WAIT_V(8); PG8_WAIT_L(0); PG8_BAR; PG8_MMA(0, 0, At, B0); PG8_MMA(0, 1, At, B1); PG8_BAR; PG8_SCHED;
            PG8_LDA(At, 0, 1); PG8_STAGE(PG8_SB(0, 0), b2, voffB); PG8_STAGE(PG8_SB(0, 1), b2 + hstepB, voffB); PG8_STAGE(PG8_SA(0, 0), a2, voffA);
            PG8_WAIT_V(8); PG8_WAIT_L(0); PG8_BAR; PG8_MMA(1, 0, At, B0); PG8_MMA(1, 1, At, B1); PG8_BAR; PG8_SCHED;
            PG8_LDB(B0, 1, 0); PG8_LDB(B1, 1, 1); PG8_SCHED; PG8_LDA(At, 1, 0); PG8_STAGE(PG8_SA(0, 1), a2 + hstepA, voffA);
            PG8_WAIT_V(8); PG8_WAIT_L(0); PG8_BAR; PG8_MMA(0, 0, At, B0); PG8_MMA(0, 1, At, B1); PG8_BAR; PG8_SCHED;
            PG8_LDA(At, 1, 1); PG8_STAGE(PG8_SB(1, 0), b3, voffB); PG8_STAGE(PG8_SB(1, 1), b3 + hstepB, voffB); PG8_STAGE(PG8_SA(1, 0), a3, voffA);
            PG8_WAIT_V(8); PG8_WAIT_L(0); PG8_BAR; PG8_MMA(1, 0, At, B0); PG8_MMA(1, 1, At, B1); PG8_BAR; PG8_SCHED;
        }
        if constexpr (ALIGN) { if (wr == 0) PG8_BAR; }
        E(acc, cur, wr, wc, fr, fq);
        if (!has_next) break;
#pragma unroll
        for (int a = 0; a < 2; ++a)
#pragma unroll
            for (int b = 0; b < 2; ++b)
#pragma unroll
                for (int m = 0; m < 4; ++m)
#pragma unroll
                    for (int n = 0; n < 2; ++n) acc[a][b][m][n] = (f32x4){0.f, 0.f, 0.f, 0.f};
        cur = nxt; cA = nA; cB = nB; ++ui;
        if constexpr (ALIGN) { if (wr == 1) PG8_BAR; }
    }
    PG8_WAIT_V(0);
    if constexpr (!ALIGN) { if (wr == 0) PG8_BAR; }
    PG8_BAR;
#undef PG8_SA
#undef PG8_SB
#undef PG8_STAGE
#undef PG8_LDA
#undef PG8_LDB
#undef PG8_MMA
#undef PG8_WAIT_V
#undef PG8_WAIT_L
#undef PG8_BAR
#undef PG8_SCHED
}
}
using pg8::Unit;

template <class Addr> struct EpiStore {
    static constexpr bool PERM = true;
    Addr ad;
    __device__ __forceinline__ void operator()(const f32x4 (&acc)[2][2][4][2], const Unit& u, int wr, int wc, int fr, int fq) const {
        asm volatile("" : "+v"(fr), "+v"(fq));
        int ldc; float sc; bf16_t* base = ad(u, ldc, sc);
        const int row0 = wr * 64 + fr, col0 = wc * 32 + 8 * fq;
#pragma unroll
        for (int ai = 0; ai < 2; ++ai)
#pragma unroll
            for (int m = 0; m < 4; ++m) { bf16_t* rowp = base + (size_t)(row0 + ai * 128 + m * 16) * ldc + col0;
#pragma unroll
                for (int bj = 0; bj < 2; ++bj) { const f32x4 v0 = acc[ai][bj][m][0] * sc, v1 = acc[ai][bj][m][1] * sc;
                    u32x4 w; w.x = cvt_pk_bf16(v0[0], v0[1]); w.y = cvt_pk_bf16(v0[2], v0[3]); w.z = cvt_pk_bf16(v1[0], v1[1]); w.w = cvt_pk_bf16(v1[2], v1[3]);
                    *(u32x4*)(rowp + bj * 128) = w; } }
    }
};
template <class Addr> struct EpiSilu {
    static constexpr bool PERM = true;
    Addr ad;
    __device__ __forceinline__ void operator()(const f32x4 (&acc)[2][2][4][2], const Unit& u, int wr, int wc, int fr, int fq) const {
        asm volatile("" : "+v"(fr), "+v"(fq));
        int ldc; float sc; bf16_t* base = ad(u, ldc, sc);
        const int row0 = wr * 64 + fr, col0 = wc * 32 + 8 * fq;
#pragma unroll
        for (int ai = 0; ai < 2; ++ai)
#pragma unroll
            for (int m = 0; m < 4; ++m) { bf16_t* rowp = base + (size_t)(row0 + ai * 128 + m * 16) * ldc + col0;
#pragma unroll
                for (int bj = 0; bj < 2; ++bj) { f32x4 v0 = acc[ai][bj][m][0], v1 = acc[ai][bj][m][1];
#pragma unroll
                    for (int e = 0; e < 4; ++e) { v0[e] = silu_f(v0[e]); v1[e] = silu_f(v1[e]); }
                    u32x4 w; w.x = cvt_pk_bf16(v0[0], v0[1]); w.y = cvt_pk_bf16(v0[2], v0[3]); w.z = cvt_pk_bf16(v1[0], v1[1]); w.w = cvt_pk_bf16(v1[2], v1[3]);
                    *(u32x4*)(rowp + bj * 128) = w; } }
    }
};
template <class Addr> struct EpiSwiglu {
    static constexpr bool PERM = true;
    Addr ad;
    __device__ __forceinline__ void operator()(const f32x4 (&acc)[2][2][4][2], const Unit& u, int wr, int wc, int fr, int fq) const {
        asm volatile("" : "+v"(fr), "+v"(fq));
        int ldc; float sc; bf16_t* base = ad(u, ldc, sc);
        const int row0 = wr * 64 + fr, col0 = wc * 32 + 8 * fq;
#pragma unroll
        for (int ai = 0; ai < 2; ++ai)
#pragma unroll
            for (int m = 0; m < 4; ++m) { bf16_t* rowp = base + (size_t)(row0 + ai * 128 + m * 16) * ldc + col0;
                f32x4 v0, v1;
#pragma unroll
                for (int e = 0; e < 4; ++e) { v0[e] = silu_f(acc[ai][0][m][0][e]) * acc[ai][1][m][0][e]; v1[e] = silu_f(acc[ai][0][m][1][e]) * acc[ai][1][m][1][e]; }
                u32x4 w; w.x = cvt_pk_bf16(v0[0], v0[1]); w.y = cvt_pk_bf16(v0[2], v0[3]); w.z = cvt_pk_bf16(v1[0], v1[1]); w.w = cvt_pk_bf16(v1[2], v1[3]);
                *(u32x4*)rowp = w; }
    }
};
struct EpiSwiglu8 {
    static constexpr bool PERM = true;
    unsigned char* base; int ld;
    __device__ __forceinline__ void operator()(const f32x4 (&acc)[2][2][4][2], const Unit& u, int wr, int wc, int fr, int fq) const {
        asm volatile("" : "+v"(fr), "+v"(fq));
        const int row0 = wr * 64 + fr, col0 = wc * 32 + 8 * fq;
#pragma unroll
        for (int ai = 0; ai < 2; ++ai)
#pragma unroll
            for (int m = 0; m < 4; ++m) { unsigned char* rowp = base + (size_t)(u.pm * 256 + row0 + ai * 128 + m * 16) * ld + (size_t)u.pn * 128 + col0;
                f32x4 v0, v1;
#pragma unroll
                for (int e = 0; e < 4; ++e) { v0[e] = silu_f(acc[ai][0][m][0][e] * 0.015625f) * (acc[ai][1][m][0][e] * 0.015625f); v1[e] = silu_f(acc[ai][0][m][1][e] * 0.015625f) * (acc[ai][1][m][1][e] * 0.015625f); }
                u32x2 w; w.x = pk4_fp8(v0[0], v0[1], v0[2], v0[3]); w.y = pk4_fp8(v1[0], v1[1], v1[2], v1[3]);
                *(u32x2*)rowp = w; }
    }
};
template <bool XF32>
struct EpiResidH {
    static constexpr bool PERM = true;
    const void* base; h16_t* out;
    __device__ __forceinline__ void operator()(const f32x4 (&acc)[2][2][4][2], const Unit& u, int wr, int wc, int fr, int fq) const {
        asm volatile("" : "+v"(fr), "+v"(fq));
        const int row0 = u.pm * 256 + wr * 64 + fr, col0 = u.pn * 256 + wc * 32 + 8 * fq;
#pragma unroll
        for (int ai = 0; ai < 2; ++ai)
#pragma unroll
            for (int m = 0; m < 4; ++m) { const size_t off = (size_t)(row0 + ai * 128 + m * 16) * D + col0;
#pragma unroll
                for (int bj = 0; bj < 2; ++bj) { f32x4 b0, b1;
                    if constexpr (XF32) { b0 = *(const f32x4*)((const float*)base + off + bj * 128); b1 = *(const f32x4*)((const float*)base + off + bj * 128 + 4); }
                    else { const u32x4 w = *(const u32x4*)((const h16_t*)base + off + bj * 128); b0 = h4_to_f32((u32x2){w.x, w.y}); b1 = h4_to_f32((u32x2){w.z, w.w}); }
                    const u32x2 o0 = f32_to_h4(b0 + acc[ai][bj][m][0]), o1 = f32_to_h4(b1 + acc[ai][bj][m][1]);
                    *(u32x4*)(out + off + bj * 128) = (u32x4){o0.x, o0.y, o1.x, o1.y}; } }
    }
};
struct EpiRetQK {
    static constexpr bool PERM = true;
    bf16_t* QB; bf16_t* KB; bf16_t* AP; bf16_t* KZ; const float* decay_logit;
    __device__ __forceinline__ void operator()(const f32x4 (&acc)[2][2][4][2], const Unit& u, int wr, int wc, int fr, int fq) const {
        asm volatile("" : "+v"(fr), "+v"(fq));
        const bool isq = u.pn < 8; const int h = u.pn & 7;
        const int row0 = wr * 64 + fr, col0 = wc * 32 + 8 * fq;
        float rf[2][4];
#pragma unroll
        for (int n = 0; n < 2; ++n)
#pragma unroll
            for (int e = 0; e < 4; ++e) rf[n][e] = __builtin_amdgcn_exp2f(-(float)(col0 + 4 * n + e) * (13.287712379549449f / 128.0f)) * 0.15915494309189535f;
        const float l2f = log2_decay(decay_logit, 0, h), l2b = log2_decay(decay_logit, 1, h);
#pragma unroll
        for (int ai = 0; ai < 2; ++ai)
#pragma unroll
            for (int m = 0; m < 4; ++m) {
                const int j = row0 + ai * 128 + m * 16; const int tok = u.pm * 256 + j; const float ftok = (float)tok;
                f32x4 x1[2], x2[2];
#pragma unroll
                for (int n = 0; n < 2; ++n)
#pragma unroll
                    for (int e = 0; e < 4; ++e) { const float rev = ftok * rf[n][e]; const float fr_ = rev - floorf(rev);
                        const float sn = __builtin_amdgcn_sinf(fr_), cs = __builtin_amdgcn_cosf(fr_);
                        const float a = acc[ai][0][m][n][e], b = acc[ai][1][m][n][e];
                        x1[n][e] = a * cs - b * sn; x2[n][e] = b * cs + a * sn; }
                if (isq) {
                    bf16_t* q = QB + (size_t)tok * 2048 + h * 256 + col0;
                    u32x4 w; w.x = cvt_pk_bf16(x1[0][0], x1[0][1]); w.y = cvt_pk_bf16(x1[0][2], x1[0][3]); w.z = cvt_pk_bf16(x1[1][0], x1[1][1]); w.w = cvt_pk_bf16(x1[1][2], x1[1][3]);
                    *(u32x4*)q = w;
                    w.x = cvt_pk_bf16(x2[0][0], x2[0][1]); w.y = cvt_pk_bf16(x2[0][2], x2[0][3]); w.z = cvt_pk_bf16(x2[1][0], x2[1][1]); w.w = cvt_pk_bf16(x2[1][2], x2[1][3]);
                    *(u32x4*)(q + 128) = w;
                    const float xf = __builtin_amdgcn_exp2f(l2f * (float)(j + 1)), xb = __builtin_amdgcn_exp2f(l2b * (float)(256 - j));
                    bf16_t* ap = AP + ((size_t)h * T + tok) * 768 + 256 + col0;
                    f32x4 y0 = x1[0] * xf, y1 = x1[1] * xf, z0 = x2[0] * xf, z1 = x2[1] * xf;
                    w.x = cvt_pk_bf16(y0[0], y0[1]); w.y = cvt_pk_bf16(y0[2], y0[3]); w.z = cvt_pk_bf16(y1[0], y1[1]); w.w = cvt_pk_bf16(y1[2], y1[3]); *(u32x4*)ap = w;
                    w.x = cvt_pk_bf16(z0[0], z0[1]); w.y = cvt_pk_bf16(z0[2], z0[3]); w.z = cvt_pk_bf16(z1[0], z1[1]); w.w = cvt_pk_bf16(z1[2], z1[3]); *(u32x4*)(ap + 128) = w;
                    y0 = x1[0] * xb; y1 = x1[1] * xb; z0 = x2[0] * xb; z1 = x2[1] * xb;
                    w.x = cvt_pk_bf16(y0[0], y0[1]); w.y = cvt_pk_bf16(y0[2], y0[3]); w.z = cvt_pk_bf16(y1[0], y1[1]); w.w = cvt_pk_bf16(y1[2], y1[3]); *(u32x4*)(ap + 256) = w;
                    w.x = cvt_pk_bf16(z0[0], z0[1]); w.y = cvt_pk_bf16(z0[2], z0[3]); w.z = cvt_pk_bf16(z1[0], z1[1]); w.w = cvt_pk_bf16(z1[2], z1[3]); *(u32x4*)(ap + 384) = w;
                } else {
                    bf16_t* k = KB + (size_t)tok * 2048 + h * 256 + col0;
                    const f32x4 y0 = x1[0] * 0.0625f, y1 = x1[1] * 0.0625f, z0 = x2[0] * 0.0625f, z1 = x2[1] * 0.0625f;
                    u32x4 w; w.x = cvt_pk_bf16(y0[0], y0[1]); w.y = cvt_pk_bf16(y0[2], y0[3]); w.z = cvt_pk_bf16(y1[0], y1[1]); w.w = cvt_pk_bf16(y1[2], y1[3]); *(u32x4*)k = w;
                    w.x = cvt_pk_bf16(z0[0], z0[1]); w.y = cvt_pk_bf16(z0[2], z0[3]); w.z = cvt_pk_bf16(z1[0], z1[1]); w.w = cvt_pk_bf16(z1[2], z1[3]); *(u32x4*)(k + 128) = w;
                    const float zf = __builtin_amdgcn_exp2f(l2f * (float)(255 - j)), zb = __builtin_amdgcn_exp2f(l2b * (float)j);
                    bf16_t* kzf = KZ + ((size_t)(h * 256 + col0)) * T + tok; bf16_t* kzb = kzf + (size_t)2048 * T;
                    const int odd = fr & 1;
#pragma unroll
                    for (int n = 0; n < 2; ++n)
#pragma unroll
                        for (int p = 0; p < 2; ++p) { const float alo = n ? y1[2 * p] : y0[2 * p], ahi = n ? y1[2 * p + 1] : y0[2 * p + 1], blo = n ? z1[2 * p] : z0[2 * p], bhi = n ? z1[2 * p + 1] : z0[2 * p + 1];
                            const size_t o = (size_t)(4 * n + 2 * p + odd) * T - odd;
#pragma unroll
                            for (int dir = 0; dir < 2; ++dir) { const float z = dir ? zb : zf; bf16_t* kz = dir ? kzb : kzf;
                                const float keepa = (odd ? ahi : alo) * z, keepb = (odd ? bhi : blo) * z;
                                const float ra = __shfl_xor((odd ? alo : ahi) * z, 1), rb = __shfl_xor((odd ? blo : bhi) * z, 1);
                                *(unsigned*)(kz + o) = odd ? cvt_pk_bf16(ra, keepa) : cvt_pk_bf16(keepa, ra);
                                *(unsigned*)(kz + o + (size_t)128 * T) = odd ? cvt_pk_bf16(rb, keepb) : cvt_pk_bf16(keepb, rb); } }
                }
                __builtin_amdgcn_sched_barrier(0);
            }
    }
};
struct EpiRetScores {
    static constexpr bool PERM = true;
    bf16_t* AP; const float* decay_logit;
    __device__ __forceinline__ void operator()(const f32x4 (&acc)[2][2][4][2], const Unit& u, int wr, int wc, int fr, int fq) const {
        asm volatile("" : "+v"(fr), "+v"(fq));
        const int h = u.pm >> 6, ci = u.pm & 63; const int row0 = wr * 64 + fr, col0 = wc * 32 + 8 * fq;
        const float l2f = log2_decay(decay_logit, 0, h), l2b = log2_decay(decay_logit, 1, h);
#pragma unroll
        for (int ai = 0; ai < 2; ++ai)
#pragma unroll
            for (int m = 0; m < 4; ++m) { const int n_ = row0 + ai * 128 + m * 16; bf16_t* rowp = AP + ((size_t)h * T + ci * 256 + n_) * 768 + col0;
#pragma unroll
                for (int bj = 0; bj < 2; ++bj) { f32x4 v[2];
#pragma unroll
                    for (int n = 0; n < 2; ++n)
#pragma unroll
                        for (int e = 0; e < 4; ++e) { const int mm = bj * 128 + col0 + 4 * n + e; const float d = (float)(n_ - mm);
                            const float dec = __builtin_amdgcn_exp2f(l2f * fmaxf(d, 0.f) + l2b * fmaxf(-d, 0.f)); v[n][e] = acc[ai][bj][m][n][e] * dec; }
                    u32x4 w; w.x = cvt_pk_bf16(v[0][0], v[0][1]); w.y = cvt_pk_bf16(v[0][2], v[0][3]); w.z = cvt_pk_bf16(v[1][0], v[1][1]); w.w = cvt_pk_bf16(v[1][2], v[1][3]);
                    *(u32x4*)(rowp + bj * 128) = w; }
                __builtin_amdgcn_sched_barrier(0); }
    }
};
struct EpiWqk {
    static constexpr bool PERM = true;
    bf16_t* WQK; unsigned* cmax; float sc;
    __device__ __forceinline__ void operator()(const f32x4 (&acc)[2][2][4][2], const Unit& u, int wr, int wc, int fr, int fq) const {
        asm volatile("" : "+v"(fr), "+v"(fq));
        const int row0 = wr * 64 + fr, col0 = wc * 32 + 8 * fq; const int L = u.pn >> 3;
#pragma unroll
        for (int ai = 0; ai < 2; ++ai)
#pragma unroll
            for (int m = 0; m < 4; ++m) { const int row = u.pm * 256 + row0 + ai * 128 + m * 16; bf16_t* rowp = WQK + (size_t)row * 4096 + u.pn * 256 + col0; float mx = 0.f;
#pragma unroll
                for (int bj = 0; bj < 2; ++bj) { const f32x4 v0 = acc[ai][bj][m][0] * sc, v1 = acc[ai][bj][m][1] * sc;
                    u32x4 w; w.x = cvt_pk_bf16(v0[0], v0[1]); w.y = cvt_pk_bf16(v0[2], v0[3]); w.z = cvt_pk_bf16(v1[0], v1[1]); w.w = cvt_pk_bf16(v1[2], v1[3]);
                    *(u32x4*)(rowp + bj * 128) = w;
                    mx = fmaxf(mx, fmaxf(fmaxf(fabsf(bf_lo(w.x)), fabsf(bf_hi(w.x))), fmaxf(fabsf(bf_lo(w.y)), fabsf(bf_hi(w.y)))));
                    mx = fmaxf(mx, fmaxf(fmaxf(fabsf(bf_lo(w.z)), fabsf(bf_hi(w.z))), fmaxf(fabsf(bf_lo(w.w)), fabsf(bf_hi(w.w))))); }
                mx = fmaxf(mx, __shfl_xor(mx, 16)); mx = fmaxf(mx, __shfl_xor(mx, 32));
                if (fq == 0) atomicMax(cmax + L * 1024 + row, __float_as_uint(mx)); }
    }
};
struct EpiMemKV {
    static constexpr bool PERM = true;
    bf16_t* MK; bf16_t* MV;
    __device__ __forceinline__ void operator()(const f32x4 (&acc)[2][2][4][2], const Unit& u, int wr, int wc, int fr, int fq) const {
        asm volatile("" : "+v"(fr), "+v"(fq));
        const int row0 = wr * 64 + fr, col0 = wc * 32 + 8 * fq;
#pragma unroll
        for (int ai = 0; ai < 2; ++ai)
#pragma unroll
            for (int m = 0; m < 4; ++m) { const int key = row0 + ai * 128 + m * 16;
#pragma unroll
                for (int bj = 0; bj < 2; ++bj) { const int n_ = u.pn * 256 + bj * 128 + col0; const int nn = n_ & 511; const int h = nn >> 7;
                    bf16_t* dst = (n_ < 512 ? MK : MV) + ((size_t)(h * 256 + key)) * 512 + nn;
                    const f32x4 v0 = acc[ai][bj][m][0], v1 = acc[ai][bj][m][1];
                    u32x4 w; w.x = cvt_pk_bf16(v0[0], v0[1]); w.y = cvt_pk_bf16(v0[2], v0[3]); w.z = cvt_pk_bf16(v1[0], v1[1]); w.w = cvt_pk_bf16(v1[2], v1[3]);
                    *(u32x4*)dst = w; } }
    }
};
struct EpiNaQK {
    static constexpr bool PERM = true;
    bf16_t* Q; bf16_t* Kb;
    __device__ __forceinline__ void operator()(const f32x4 (&acc)[2][2][4][2], const Unit& u, int wr, int wc, int fr, int fq) const {
        asm volatile("" : "+v"(fr), "+v"(fq));
        const bool isq = u.pn < 8; const float sc = isq ? 0.08838834764831845f : 1.f;
        const int row0 = wr * 64 + fr, col0 = wc * 32 + 8 * fq;
#pragma unroll
        for (int ai = 0; ai < 2; ++ai)
#pragma unroll
            for (int m = 0; m < 4; ++m) { const int tok = u.pm * 256 + row0 + ai * 128 + m * 16;
#pragma unroll
                for (int bj = 0; bj < 2; ++bj) { const f32x4 v0 = acc[ai][bj][m][0] * sc, v1 = acc[ai][bj][m][1] * sc;
                    u32x4 w; w.x = cvt_pk_bf16(v0[0], v0[1]); w.y = cvt_pk_bf16(v0[2], v0[3]); w.z = cvt_pk_bf16(v1[0], v1[1]); w.w = cvt_pk_bf16(v1[2], v1[3]);
                    const int head = 2 * (u.pn & 7) + bj;
                    bf16_t* dst = isq ? Q + (size_t)tok * 2048 + head * 128 + col0
                                      : Kb + (size_t)head * T * 128 + (size_t)(tok >> 3) * 1024 + ((tok >> 2) & 1) * 512 + (col0 >> 3) * 32 + (tok & 3) * 8;
                    *(u32x4*)dst = w; } }
    }
};
struct EpiNaV {
    static constexpr bool PERM = true;
    bf16_t* Vb;
    __device__ __forceinline__ void operator()(const f32x4 (&acc)[2][2][4][2], const Unit& u, int wr, int wc, int fr, int fq) const {
        asm volatile("" : "+v"(fr), "+v"(fq));
        const int row0 = wr * 64 + fr, col0 = wc * 32 + 8 * fq;
#pragma unroll
        for (int ai = 0; ai < 2; ++ai)
#pragma unroll
            for (int m = 0; m < 4; ++m) { const int head = 2 * u.pm + ai, d = row0 + m * 16;
#pragma unroll
                for (int bj = 0; bj < 2; ++bj) { const int tok = u.pn * 256 + bj * 128 + col0;
                    bf16_t* dst = Vb + (size_t)head * T * 128 + ((size_t)(tok >> 2) * 128 + d) * 4;
                    const f32x4 v0 = acc[ai][bj][m][0], v1 = acc[ai][bj][m][1];
                    u32x2 a, b; a.x = cvt_pk_bf16(v0[0], v0[1]); a.y = cvt_pk_bf16(v0[2], v0[3]); b.x = cvt_pk_bf16(v1[0], v1[1]); b.y = cvt_pk_bf16(v1[2], v1[3]);
                    *(u32x2*)dst = a; *(u32x2*)(dst + 512) = b; } }
    }
};
__device__ __forceinline__ f32x4 i32_to_f32(f32x4 bits) { const v4i32 i = __builtin_bit_cast(v4i32, bits); return (f32x4){(float)i[0], (float)i[1], (float)i[2], (float)i[3]}; }
struct EpiSwiglu8i {
    static constexpr bool PERM = true;
    bf16_t* base; int ld; const float* rs; const unsigned* cmax;
    __device__ __forceinline__ void operator()(const f32x4 (&acc)[2][2][4][2], const Unit& u, int wr, int wc, int fr, int fq) const {
        asm volatile("" : "+v"(fr), "+v"(fq));
        const int row0 = wr * 64 + fr, col0 = wc * 32 + 8 * fq;
        f32x4 cs[2][2];
#pragma unroll
        for (int bj = 0; bj < 2; ++bj)
#pragma unroll
            for (int n = 0; n < 2; ++n) { const u32x4 c = *(const u32x4*)(cmax + u.pn * 256 + bj * 128 + col0 + 4 * n); cs[bj][n] = (f32x4){__uint_as_float(c.x), __uint_as_float(c.y), __uint_as_float(c.z), __uint_as_float(c.w)} * (1.0f / 127.0f); }
#pragma unroll
        for (int ai = 0; ai < 2; ++ai)
#pragma unroll
            for (int m = 0; m < 4; ++m) { const int row = u.pm * 256 + row0 + ai * 128 + m * 16; const float r = rs[row];
                bf16_t* rowp = base + (size_t)row * ld + (size_t)u.pn * 128 + col0;
                const f32x4 g0 = i32_to_f32(acc[ai][0][m][0]) * cs[0][0] * r, g1 = i32_to_f32(acc[ai][0][m][1]) * cs[0][1] * r, u0 = i32_to_f32(acc[ai][1][m][0]) * cs[1][0] * r, u1 = i32_to_f32(acc[ai][1][m][1]) * cs[1][1] * r;
                f32x4 v0, v1;
#pragma unroll
                for (int e = 0; e < 4; ++e) { v0[e] = silu_f(g0[e]) * u0[e]; v1[e] = silu_f(g1[e]) * u1[e]; }
                u32x4 w; w.x = cvt_pk_bf16(v0[0], v0[1]); w.y = cvt_pk_bf16(v0[2], v0[3]); w.z = cvt_pk_bf16(v1[0], v1[1]); w.w = cvt_pk_bf16(v1[2], v1[3]);
                *(u32x4*)rowp = w; }
    }
};
struct EpiRetQK8 {
    static constexpr bool PERM = true;
    bf16_t* QB; bf16_t* KB; bf16_t* AP; bf16_t* KZ; const float* decay_logit; const float* rs; const unsigned* cmax;
    __device__ __forceinline__ void operator()(const f32x4 (&acc)[2][2][4][2], const Unit& u, int wr, int wc, int fr, int fq) const {
        asm volatile("" : "+v"(fr), "+v"(fq));
        const bool isq = u.pn < 8; const int h = u.pn & 7;
        const int row0 = wr * 64 + fr, col0 = wc * 32 + 8 * fq;
        float rf[2][4]; f32x4 cs[2][2];
#pragma unroll
        for (int n = 0; n < 2; ++n)
#pragma unroll
            for (int e = 0; e < 4; ++e) rf[n][e] = __builtin_amdgcn_exp2f(-(float)(col0 + 4 * n + e) * (13.287712379549449f / 128.0f)) * 0.15915494309189535f;
#pragma unroll
        for (int bj = 0; bj < 2; ++bj)
#pragma unroll
            for (int n = 0; n < 2; ++n) { const u32x4 c = *(const u32x4*)(cmax + u.pn * 256 + bj * 128 + col0 + 4 * n); cs[bj][n] = (f32x4){__uint_as_float(c.x), __uint_as_float(c.y), __uint_as_float(c.z), __uint_as_float(c.w)} * (1.0f / 127.0f); }
        const float l2f = log2_decay(decay_logit, 0, h), l2b = log2_decay(decay_logit, 1, h);
#pragma unroll
        for (int ai = 0; ai < 2; ++ai)
#pragma unroll
            for (int m = 0; m < 4; ++m) {
                const int j = row0 + ai * 128 + m * 16; const int tok = u.pm * 256 + j; const float ftok = (float)tok; const float r = rs[tok];
                f32x4 x1[2], x2[2];
#pragma unroll
                for (int n = 0; n < 2; ++n) { const f32x4 av = i32_to_f32(acc[ai][0][m][n]) * cs[0][n] * r, bv = i32_to_f32(acc[ai][1][m][n]) * cs[1][n] * r;
#pragma unroll
                    for (int e = 0; e < 4; ++e) { const float rev = ftok * rf[n][e]; const float fr_ = rev - floorf(rev);
                        const float sn = __builtin_amdgcn_sinf(fr_), cv = __builtin_amdgcn_cosf(fr_);
                        x1[n][e] = av[e] * cv - bv[e] * sn; x2[n][e] = bv[e] * cv + av[e] * sn; } }
                if (isq) {
                    bf16_t* q = QB + (size_t)tok * 2048 + h * 256 + col0;
                    u32x4 w; w.x = cvt_pk_bf16(x1[0][0], x1[0][1]); w.y = cvt_pk_bf16(x1[0][2], x1[0][3]); w.z = cvt_pk_bf16(x1[1][0], x1[1][1]); w.w = cvt_pk_bf16(x1[1][2], x1[1][3]);
                    *(u32x4*)q = w;
                    w.x = cvt_pk_bf16(x2[0][0], x2[0][1]); w.y = cvt_pk_bf16(x2[0][2], x2[0][3]); w.z = cvt_pk_bf16(x2[1][0], x2[1][1]); w.w = cvt_pk_bf16(x2[1][2], x2[1][3]);
                    *(u32x4*)(q + 128) = w;
                    const float xf = __builtin_amdgcn_exp2f(l2f * (float)(j + 1)), xb = __builtin_amdgcn_exp2f(l2b * (float)(256 - j));
                    bf16_t* ap = AP + ((size_t)h * T + tok) * 768 + 256 + col0;
                    f32x4 y0 = x1[0] * xf, y1 = x1[1] * xf, z0 = x2[0] * xf, z1 = x2[1] * xf;
                    w.x = cvt_pk_bf16(y0[0], y0[1]); w.y = cvt_pk_bf16(y0[2], y0[3]); w.z = cvt_pk_bf16(y1[0], y1[1]); w.w = cvt_pk_bf16(y1[2], y1[3]); *(u32x4*)ap = w;
                    w.x = cvt_pk_bf16(z0[0], z0[1]); w.y = cvt_pk_bf16(z0[2], z0[3]); w.z = cvt_pk_bf16(z1[0], z1[1]); w.w = cvt_pk_bf16(z1[2], z1[3]); *(u32x4*)(ap + 128) = w;
                    y0 = x1[0] * xb; y1 = x1[1] * xb; z0 = x2[0] * xb; z1 = x2[1] * xb;
                    w.x = cvt_pk_bf16(y0[0], y0[1]); w.y = cvt_pk_bf16(y0[2], y0[3]); w.z = cvt_pk_bf16(y1[0], y1[1]); w.w = cvt_pk_bf16(y1[2], y1[3]); *(u32x4*)(ap + 256) = w;
                    w.x = cvt_pk_bf16(z0[0], z0[1]); w.y = cvt_pk_bf16(z0[2], z0[3]); w.z = cvt_pk_bf16(z1[0], z1[1]); w.w = cvt_pk_bf16(z1[2], z1[3]); *(u32x4*)(ap + 384) = w;
                } else {
                    bf16_t* k = KB + (size_t)tok * 2048 + h * 256 + col0;
                    const f32x4 y0 = x1[0] * 0.0625f, y1 = x1[1] * 0.0625f, z0 = x2[0] * 0.0625f, z1 = x2[1] * 0.0625f;
                    u32x4 w; w.x = cvt_pk_bf16(y0[0], y0[1]); w.y = cvt_pk_bf16(y0[2], y0[3]); w.z = cvt_pk_bf16(y1[0], y1[1]); w.w = cvt_pk_bf16(y1[2], y1[3]); *(u32x4*)k = w;
                    w.x = cvt_pk_bf16(z0[0], z0[1]); w.y = cvt_pk_bf16(z0[2], z0[3]); w.z = cvt_pk_bf16(z1[0], z1[1]); w.w = cvt_pk_bf16(z1[2], z1[3]); *(u32x4*)(k + 128) = w;
                    const float zf = __builtin_amdgcn_exp2f(l2f * (float)(255 - j)), zb = __builtin_amdgcn_exp2f(l2b * (float)j);
                    bf16_t* kzf = KZ + ((size_t)(h * 256 + col0)) * T + tok; bf16_t* kzb = kzf + (size_t)2048 * T;
                    const int odd = fr & 1;
#pragma unroll
                    for (int n = 0; n < 2; ++n)
#pragma unroll
                        for (int p = 0; p < 2; ++p) { const float alo = n ? y1[2 * p] : y0[2 * p], ahi = n ? y1[2 * p + 1] : y0[2 * p + 1], blo = n ? z1[2 * p] : z0[2 * p], bhi = n ? z1[2 * p + 1] : z0[2 * p + 1];
                            const size_t o = (size_t)(4 * n + 2 * p + odd) * T - odd;
#pragma unroll
                            for (int dir = 0; dir < 2; ++dir) { const float z = dir ? zb : zf; bf16_t* kz = dir ? kzb : kzf;
                                const float keepa = (odd ? ahi : alo) * z, keepb = (odd ? bhi : blo) * z;
                                const float ra = __shfl_xor((odd ? alo : ahi) * z, 1), rb = __shfl_xor((odd ? blo : bhi) * z, 1);
                                *(unsigned*)(kz + o) = odd ? cvt_pk_bf16(ra, keepa) : cvt_pk_bf16(keepa, ra);
                                *(unsigned*)(kz + o + (size_t)128 * T) = odd ? cvt_pk_bf16(rb, keepb) : cvt_pk_bf16(keepb, rb); } }
                }
                __builtin_amdgcn_sched_barrier(0);
            }
    }
};
struct EpiSilu8i {
    static constexpr bool PERM = true;
    bf16_t* GB; const float* rs; const unsigned* cmax;
    __device__ __forceinline__ void operator()(const f32x4 (&acc)[2][2][4][2], const Unit& u, int wr, int wc, int fr, int fq) const {
        asm volatile("" : "+v"(fr), "+v"(fq));
        const int row0 = wr * 64 + fr, col0 = wc * 32 + 8 * fq;
        f32x4 cs[2][2];
#pragma unroll
        for (int bj = 0; bj < 2; ++bj)
#pragma unroll
            for (int n = 0; n < 2; ++n) { const u32x4 c = *(const u32x4*)(cmax + u.pn * 256 + bj * 128 + col0 + 4 * n); cs[bj][n] = (f32x4){__uint_as_float(c.x), __uint_as_float(c.y), __uint_as_float(c.z), __uint_as_float(c.w)} * (1.0f / 127.0f); }
#pragma unroll
        for (int ai = 0; ai < 2; ++ai)
#pragma unroll
            for (int m = 0; m < 4; ++m) { const int tok = u.pm * 256 + row0 + ai * 128 + m * 16; const float r = rs[tok]; bf16_t* rowp = GB + (size_t)tok * 4096 + u.pn * 256 + col0;
#pragma unroll
                for (int bj = 0; bj < 2; ++bj) { f32x4 v0 = i32_to_f32(acc[ai][bj][m][0]) * cs[bj][0] * r, v1 = i32_to_f32(acc[ai][bj][m][1]) * cs[bj][1] * r;
#pragma unroll
                    for (int e = 0; e < 4; ++e) { v0[e] = silu_f(v0[e]); v1[e] = silu_f(v1[e]); }
                    u32x4 w; w.x = cvt_pk_bf16(v0[0], v0[1]); w.y = cvt_pk_bf16(v0[2], v0[3]); w.z = cvt_pk_bf16(v1[0], v1[1]); w.w = cvt_pk_bf16(v1[2], v1[3]);
                    *(u32x4*)(rowp + bj * 128) = w; } }
    }
};
struct EpiRetV8 {
    static constexpr bool PERM = true;
    bf16_t* BS; const float* rs; const unsigned* cmax;
    __device__ __forceinline__ void operator()(const f32x4 (&acc)[2][2][4][2], const Unit& u, int wr, int wc, int fr, int fq) const {
        asm volatile("" : "+v"(fr), "+v"(fq));
        const int row0 = wr * 64 + fr, col0 = wc * 32 + 8 * fq;
        bf16_t* base = BS + (((size_t)(u.pm >> 1) * 64 + u.pn) * 512 + (u.pm & 1) * 256) * 768;
        f32x4 rc[2][2];
#pragma unroll
        for (int bj = 0; bj < 2; ++bj) { rc[bj][0] = *(const f32x4*)(rs + u.pn * 256 + bj * 128 + col0); rc[bj][1] = *(const f32x4*)(rs + u.pn * 256 + bj * 128 + col0 + 4); }
#pragma unroll
        for (int ai = 0; ai < 2; ++ai)
#pragma unroll
            for (int m = 0; m < 4; ++m) { const int r_ = row0 + ai * 128 + m * 16; const float cw = __uint_as_float(cmax[4096 + u.pm * 256 + r_]) * (1.0f / 127.0f);
                bf16_t* rowp = base + (size_t)r_ * 768 + col0;
#pragma unroll
                for (int bj = 0; bj < 2; ++bj) { const f32x4 v0 = i32_to_f32(acc[ai][bj][m][0]) * rc[bj][0] * cw, v1 = i32_to_f32(acc[ai][bj][m][1]) * rc[bj][1] * cw;
                    u32x4 w; w.x = cvt_pk_bf16(v0[0], v0[1]); w.y = cvt_pk_bf16(v0[2], v0[3]); w.z = cvt_pk_bf16(v1[0], v1[1]); w.w = cvt_pk_bf16(v1[2], v1[3]);
                    *(u32x4*)(rowp + bj * 128) = w; } }
    }
};
struct EpiNaQK8 {
    static constexpr bool PERM = true;
    bf16_t* Q; bf16_t* Kb; const float* rs; const unsigned* cmax;
    __device__ __forceinline__ void operator()(const f32x4 (&acc)[2][2][4][2], const Unit& u, int wr, int wc, int fr, int fq) const {
        asm volatile("" : "+v"(fr), "+v"(fq));
        const bool isq = u.pn < 8; const float sc0 = (isq ? 0.08838834764831845f : 1.f) * (1.0f / 127.0f);
        const int row0 = wr * 64 + fr, col0 = wc * 32 + 8 * fq;
        f32x4 cs[2][2];
#pragma unroll
        for (int bj = 0; bj < 2; ++bj)
#pragma unroll
            for (int n = 0; n < 2; ++n) { const u32x4 c = *(const u32x4*)(cmax + u.pn * 256 + bj * 128 + col0 + 4 * n); cs[bj][n] = (f32x4){__uint_as_float(c.x), __uint_as_float(c.y), __uint_as_float(c.z), __uint_as_float(c.w)} * sc0; }
#pragma unroll
        for (int ai = 0; ai < 2; ++ai)
#pragma unroll
            for (int m = 0; m < 4; ++m) { const int tok = u.pm * 256 + row0 + ai * 128 + m * 16; const float r = rs[tok];
#pragma unroll
                for (int bj = 0; bj < 2; ++bj) { const f32x4 v0 = i32_to_f32(acc[ai][bj][m][0]) * cs[bj][0] * r, v1 = i32_to_f32(acc[ai][bj][m][1]) * cs[bj][1] * r;
                    u32x4 w; w.x = cvt_pk_bf16(v0[0], v0[1]); w.y = cvt_pk_bf16(v0[2], v0[3]); w.z = cvt_pk_bf16(v1[0], v1[1]); w.w = cvt_pk_bf16(v1[2], v1[3]);
                    const int head = 2 * (u.pn & 7) + bj;
                    bf16_t* dst = isq ? Q + (size_t)tok * 2048 + head * 128 + col0
                                      : Kb + (size_t)head * T * 128 + (size_t)(tok >> 3) * 1024 + ((tok >> 2) & 1) * 512 + (col0 >> 3) * 32 + (tok & 3) * 8;
                    *(u32x4*)dst = w; } }
    }
};
struct EpiNaV8 {
    static constexpr bool PERM = true;
    bf16_t* Vb; const float* rs; const unsigned* cmax;
    __device__ __forceinline__ void operator()(const f32x4 (&acc)[2][2][4][2], const Unit& u, int wr, int wc, int fr, int fq) const {
        asm volatile("" : "+v"(fr), "+v"(fq));
        const int row0 = wr * 64 + fr, col0 = wc * 32 + 8 * fq;
        f32x4 rc[2][2];
#pragma unroll
        for (int bj = 0; bj < 2; ++bj) { rc[bj][0] = *(const f32x4*)(rs + u.pn * 256 + bj * 128 + col0); rc[bj][1] = *(const f32x4*)(rs + u.pn * 256 + bj * 128 + col0 + 4); }
#pragma unroll
        for (int ai = 0; ai < 2; ++ai)
#pragma unroll
            for (int m = 0; m < 4; ++m) { const int head = 2 * u.pm + ai, d = row0 + m * 16;
                const float cw = __uint_as_float(cmax[4096 + u.pm * 256 + ai * 128 + d]) * (1.0f / 127.0f);
#pragma unroll
                for (int bj = 0; bj < 2; ++bj) { const int tok = u.pn * 256 + bj * 128 + col0;
                    bf16_t* dst = Vb + (size_t)head * T * 128 + ((size_t)(tok >> 3) * 128 + d) * 8;
                    const f32x4 v0 = i32_to_f32(acc[ai][bj][m][0]) * rc[bj][0] * cw, v1 = i32_to_f32(acc[ai][bj][m][1]) * rc[bj][1] * cw;
                    u32x4 w; w.x = cvt_pk_bf16(v0[0], v0[1]); w.y = cvt_pk_bf16(v0[2], v0[3]); w.z = cvt_pk_bf16(v1[0], v1[1]); w.w = cvt_pk_bf16(v1[2], v1[3]);
                    *(u32x4*)dst = w; } }
    }
};
struct EpiXaSoftmax {
    static constexpr bool PERM = true;
    bf16_t* XP; LAS unsigned char* ex; const float* rs; const unsigned* cmax;
    __device__ __forceinline__ void operator()(const f32x4 (&acc)[2][2][4][2], const Unit& u, int wr, int wc, int fr, int fq) const {
        asm volatile("" : "+v"(fr), "+v"(fq));
        const int row0 = wr * 64 + fr, col0 = wc * 32 + 8 * fq;
        LAS f32x2* X = (LAS f32x2*)ex;
        f32x4 cs[2][2];
#pragma unroll
        for (int bj = 0; bj < 2; ++bj)
#pragma unroll
            for (int n = 0; n < 2; ++n) { const u32x4 c = *(const u32x4*)(cmax + u.pn * 256 + bj * 128 + col0 + 4 * n); cs[bj][n] = (f32x4){__uint_as_float(c.x), __uint_as_float(c.y), __uint_as_float(c.z), __uint_as_float(c.w)} * (1.0f / 127.0f); }
        float mw[2][4], p[2][4][2][2][4];
#pragma unroll
        for (int ai = 0; ai < 2; ++ai)
#pragma unroll
            for (int m = 0; m < 4; ++m) {
                const float r = rs[u.pm * 256 + row0 + ai * 128 + m * 16];
                f32x4 sv[2][2];
#pragma unroll
                for (int bj = 0; bj < 2; ++bj)
#pragma unroll
                    for (int n = 0; n < 2; ++n) sv[bj][n] = i32_to_f32(acc[ai][bj][m][n]) * cs[bj][n] * r;
                float mx = -3.0e38f;
#pragma unroll
                for (int bj = 0; bj < 2; ++bj)
#pragma unroll
                    for (int n = 0; n < 2; ++n)
#pragma unroll
                        for (int e = 0; e < 4; ++e) mx = fmaxf(mx, sv[bj][n][e]);
                mx = fmaxf(mx, __shfl_xor(mx, 16)); mx = fmaxf(mx, __shfl_xor(mx, 32));
                float s = 0.f;
#pragma unroll
                for (int bj = 0; bj < 2; ++bj)
#pragma unroll
                    for (int n = 0; n < 2; ++n)
#pragma unroll
                        for (int e = 0; e < 4; ++e) { const float q = fast_exp(sv[bj][n][e] - mx); p[ai][m][bj][n][e] = q; s += q; }
                s += __shfl_xor(s, 16); s += __shfl_xor(s, 32);
                mw[ai][m] = mx;
                if (fq == 0) X[(row0 + ai * 128 + m * 16) * 4 + wc] = (f32x2){mx, s};
            }
        LDS_WAIT(); __builtin_amdgcn_s_barrier(); asm volatile("" ::: "memory");
#pragma unroll
        for (int ai = 0; ai < 2; ++ai)
#pragma unroll
            for (int m = 0; m < 4; ++m) {
                const int r = row0 + ai * 128 + m * 16;
                const f32x2 a = X[r * 4 + 0], b = X[r * 4 + 1], c = X[r * 4 + 2], d = X[r * 4 + 3];
                const float M = fmaxf(fmaxf(a.x, b.x), fmaxf(c.x, d.x));
                const float tot = a.y * fast_exp(a.x - M) + b.y * fast_exp(b.x - M) + c.y * fast_exp(c.x - M) + d.y * fast_exp(d.x - M);
                const float f = fast_exp(mw[ai][m] - M) * __builtin_amdgcn_rcpf(tot);
                bf16_t* rowp = XP + (size_t)(u.pm * 256 + r) * 1024 + u.pn * 256 + col0;
#pragma unroll
                for (int bj = 0; bj < 2; ++bj) { u32x4 w;
                    w.x = cvt_pk_bf16(p[ai][m][bj][0][0] * f, p[ai][m][bj][0][1] * f); w.y = cvt_pk_bf16(p[ai][m][bj][0][2] * f, p[ai][m][bj][0][3] * f);
                    w.z = cvt_pk_bf16(p[ai][m][bj][1][0] * f, p[ai][m][bj][1][1] * f); w.w = cvt_pk_bf16(p[ai][m][bj][1][2] * f, p[ai][m][bj][1][3] * f);
                    *(u32x4*)(rowp + bj * 128) = w; }
            }
        LDS_WAIT(); __builtin_amdgcn_s_barrier(); asm volatile("" ::: "memory");
    }
};

struct Args { const float* in[22]; float* out; unsigned char* ws; };
struct Frame {
    LAS unsigned char* lds; volatile LAS unsigned* MISC;
    int wave, G, gw, NGW;
};

struct AdSimple { bf16_t* base; int ld; float sc; int colw;
    __device__ __forceinline__ bf16_t* operator()(const Unit& u, int& ldc, float& s) const { ldc = ld; s = sc; return base + (size_t)u.pm * 256 * ld + (size_t)u.pn * colw; } };
struct AdRetV { bf16_t* BS;
    __device__ __forceinline__ bf16_t* operator()(const Unit& u, int& ldc, float& s) const { ldc = 768; s = 1.f; return BS + (((size_t)(u.pm >> 1) * 64 + u.pn) * 512 + (u.pm & 1) * 256) * 768; } };
struct AdRetKV { bf16_t* BS;
    __device__ __forceinline__ bf16_t* operator()(const Unit& u, int& ldc, float& s) const { ldc = 768; s = 1.f; return BS + ((size_t)(u.pm >> 1) * 512 + (u.pm & 1) * 256) * 768 + 256 + u.pn * 256; } };
struct AdRetY { bf16_t* Y;
    __device__ __forceinline__ bf16_t* operator()(const Unit& u, int& ldc, float& s) const { ldc = 4096; s = 1.f; return Y + (size_t)(u.pm & 63) * 256 * 4096 + (u.pm >> 6) * 512 + u.pn * 256; } };
struct AdNaQK { bf16_t* Q; bf16_t* Kk;
    __device__ __forceinline__ bf16_t* operator()(const Unit& u, int& ldc, float& s) const { ldc = 2048; s = u.pn < 8 ? 0.08838834764831845f : 1.f; return (u.pn < 8 ? Q : Kk) + (size_t)u.pm * 256 * 2048 + (u.pn & 7) * 256; } };
struct AdMoe { bf16_t* base; int ld; int colw; float sc;
    __device__ __forceinline__ bf16_t* operator()(const Unit& u, int& ldc, float& s) const { ldc = ld; s = sc; return base + (size_t)u.pm * 256 * ld + (size_t)u.pn * colw; } };

struct MapAB { const bf16_t* A; const bf16_t* B; size_t sa, sb;
    __device__ __forceinline__ void operator()(const Unit& u, const char*& a, const char*& b) const { a = (const char*)(A + (size_t)u.pm * sa); b = (const char*)(B + (size_t)u.pn * sb); } };
struct MapAB8 { const unsigned char* A; const unsigned char* B; size_t sa, sb;
    __device__ __forceinline__ void operator()(const Unit& u, const char*& a, const char*& b) const { a = (const char*)(A + (size_t)u.pm * sa); b = (const char*)(B + (size_t)u.pn * sb); } };
struct MapRetS { const bf16_t* Q; const bf16_t* Kk;
    __device__ __forceinline__ void operator()(const Unit& u, const char*& a, const char*& b) const { const size_t o = (size_t)(u.pm & 63) * 256 * 2048 + (u.pm >> 6) * 256; a = (const char*)(Q + o); b = (const char*)(Kk + o); } };
struct MapRetKV { const bf16_t* BS; const bf16_t* KZ;
    __device__ __forceinline__ void operator()(const Unit& u, const char*& a, const char*& b) const { const int hc = u.pm >> 1, h = hc >> 6, ci = hc & 63;
        a = (const char*)(BS + ((size_t)hc * 512 + (u.pm & 1) * 256) * 768); b = (const char*)(KZ + ((size_t)(u.pn * 2048 + h * 256)) * T + ci * 256); } };
struct MapRetO { const bf16_t* AP; const bf16_t* BS;
    __device__ __forceinline__ void operator()(const Unit& u, const char*& a, const char*& b) const { const int h = u.pm >> 6, ci = u.pm & 63;
        a = (const char*)(AP + ((size_t)h * T + ci * 256) * 768); b = (const char*)(BS + ((size_t)u.pm * 512 + u.pn * 256) * 768); } };
struct MapMoe { const unsigned char* A; const unsigned char* W; size_t sa, se, sb; const volatile LAS unsigned* ts;
    __device__ __forceinline__ void operator()(const Unit& u, const char*& a, const char*& b) const { int e = 0;
#pragma unroll
        for (int j = 1; j < 8; ++j) e += (__builtin_amdgcn_readfirstlane((int)ts[j]) <= u.pm) ? 1 : 0;
        a = (const char*)(A + (size_t)u.pm * sa); b = (const char*)(W + (size_t)e * se + (size_t)u.pn * sb); } };

struct MapMoeD { const unsigned char* A; const unsigned char* W; const volatile LAS unsigned* ts;
    __device__ __forceinline__ void operator()(const Unit& u, const char*& a, const char*& b) const { int e = 0;
#pragma unroll
        for (int j = 1; j < 8; ++j) e += (__builtin_amdgcn_readfirstlane((int)ts[j]) <= u.pm) ? 1 : 0;
        const size_t ko = u.kq < 0 ? 0 : (size_t)u.kq * (EDIM / 4);
        a = (const char*)(A + (size_t)u.pm * 256 * EDIM + ko); b = (const char*)(W + ((size_t)e * 2048 + (size_t)u.pn * 256) * EDIM + ko); } };
struct EpiMoeDown {
    static constexpr bool PERM = true;
    bf16_t* Y; bf16_t* YP; int tail_row0;
    __device__ __forceinline__ void operator()(const f32x4 (&acc)[2][2][4][2], const Unit& u, int wr, int wc, int fr, int fq) const {
        asm volatile("" : "+v"(fr), "+v"(fq));
        bf16_t* base = u.kq < 0 ? Y + (size_t)u.pm * 256 * 2048 + u.pn * 256 : YP + ((size_t)u.kq * 2048 + (size_t)(u.pm * 256 - tail_row0)) * 2048 + u.pn * 256;
        const int row0 = wr * 64 + fr, col0 = wc * 32 + 8 * fq;
#pragma unroll
        for (int ai = 0; ai < 2; ++ai)
#pragma unroll
            for (int m = 0; m < 4; ++m) { bf16_t* rowp = base + (size_t)(row0 + ai * 128 + m * 16) * 2048 + col0;
#pragma unroll
                for (int bj = 0; bj < 2; ++bj) { const f32x4 v0 = acc[ai][bj][m][0] * 0.015625f, v1 = acc[ai][bj][m][1] * 0.015625f;
                    u32x4 w; w.x = cvt_pk_bf16(v0[0], v0[1]); w.y = cvt_pk_bf16(v0[2], v0[3]); w.z = cvt_pk_bf16(v1[0], v1[1]); w.w = cvt_pk_bf16(v1[2], v1[3]);
                    *(u32x4*)(rowp + bj * 128) = w; } }
    }
};

__device__ __forceinline__ void transpose_item(const float* W, int N, int k0, int n0, bf16_t* dst, int ldd, LAS unsigned* scr, int lane) {
    const int kp = lane >> 4, nq = lane & 15;
    f32x4 a[8], b[8];
#pragma unroll
    for (int it = 0; it < 8; ++it) { const float* p = W + (size_t)(k0 + 8 * it + 2 * kp) * N + n0 + 4 * nq; a[it] = *(const f32x4*)p; b[it] = *(const f32x4*)(p + N); }
#pragma unroll
    for (int it = 0; it < 8; ++it)
#pragma unroll
        for (int e = 0; e < 4; ++e) scr[(4 * nq + e) * 33 + 4 * it + kp] = cvt_pk_bf16(a[it][e], b[it][e]);
    LDS_WAIT(); asm volatile("" ::: "memory");
    const int nr = lane >> 3, c = lane & 7;
#pragma unroll
    for (int ps = 0; ps < 8; ++ps) { const int n = 8 * ps + nr; u32x4 w; w.x = scr[n * 33 + 4 * c]; w.y = scr[n * 33 + 4 * c + 1]; w.z = scr[n * 33 + 4 * c + 2]; w.w = scr[n * 33 + 4 * c + 3];
        *(u32x4*)(dst + (size_t)n * ldd + 8 * c) = w; }
    LDS_WAIT(); asm volatile("" ::: "memory");
}
__device__ __forceinline__ void conv_job(Frame& F, const float* W, int K, int N, bf16_t* WT, int ldd, int mode, int row_off, int rot) {
    int tid_ = tid_now(F.wave); asm volatile("" : "+v"(tid_)); const int lane_ = tid_ & 63;
    LAS unsigned* scr = (LAS unsigned*)(F.lds + F.wave * 8448);
    const int nnb = N / 64, nitems = (K / 64) * nnb;
    int g0 = F.gw + rot; if (g0 >= F.NGW) g0 -= F.NGW;
    for (int it = g0; it < nitems; it += F.NGW) { const int kb = it / nnb, nb = it % nnb; const int n0 = nb * 64;
        const int r0 = mode ? ((n0 >> 7) * 256 + (n0 & 127) + row_off) : (row_off + n0);
        transpose_item(W, N, kb * 64, n0, WT + (size_t)r0 * ldd + kb * 64, ldd, scr, lane_); }
}
__device__ __forceinline__ void t8_load(const float* W, int N, int k0, int n0, int lane, f32x4 (&a)[8], f32x4 (&b)[8]) {
    const int kq = lane >> 4, nq = lane & 15;
#pragma unroll
    for (int it = 0; it < 4; ++it) { const float* p = W + (size_t)(k0 + 16 * it + 4 * kq) * N + n0 + 4 * nq;
        a[2 * it] = __builtin_nontemporal_load((const f32x4*)p); b[2 * it] = __builtin_nontemporal_load((const f32x4*)(p + N));
        a[2 * it + 1] = __builtin_nontemporal_load((const f32x4*)(p + 2 * (size_t)N)); b[2 * it + 1] = __builtin_nontemporal_load((const f32x4*)(p + 3 * (size_t)N)); }
}
__device__ __forceinline__ void t8_finish(const f32x4 (&a)[8], const f32x4 (&b)[8], unsigned char* dst, int ldd, float scale, LAS unsigned* scr, int lane) {
    const int kq = lane >> 4, nq = lane & 15;
#pragma unroll
    for (int it = 0; it < 4; ++it)
#pragma unroll
        for (int e = 0; e < 4; ++e) scr[(4 * nq + e) * 17 + 4 * it + kq] = pk4_fp8(a[2 * it][e] * scale, b[2 * it][e] * scale, a[2 * it + 1][e] * scale, b[2 * it + 1][e] * scale);
    LDS_WAIT(); asm volatile("" ::: "memory");
    const int nr = lane >> 2, c = lane & 3;
#pragma unroll
    for (int ps = 0; ps < 4; ++ps) { const int n = 16 * ps + nr; u32x4 w; w.x = scr[n * 17 + 4 * c]; w.y = scr[n * 17 + 4 * c + 1]; w.z = scr[n * 17 + 4 * c + 2]; w.w = scr[n * 17 + 4 * c + 3];
        *(u32x4*)(dst + (size_t)n * ldd + 16 * c) = w; }
    LDS_WAIT(); asm volatile("" ::: "memory");
}
__device__ __forceinline__ void conv_job8(Frame& F, const float* W, int K, int N, unsigned char* WT, int ldd, int mode, int row_off, float scale) {
    int tid_ = tid_now(F.wave); asm volatile("" : "+v"(tid_)); const int lane_ = tid_ & 63;
    LAS unsigned* scr = (LAS unsigned*)(F.lds + F.wave * 8448);
    const int nnb = N / 64, nitems = (K / 64) * nnb;
#define T8_DST(it_) (WT + (size_t)(mode ? (((((it_) % nnb) * 64) >> 7) * 256 + ((((it_) % nnb) * 64) & 127) + row_off) : (row_off + ((it_) % nnb) * 64)) * ldd + ((it_) / nnb) * 64)
    f32x4 a0[8], b0[8], a1[8], b1[8];
    int it = F.gw;
    if (it < nitems) t8_load(W, N, (it / nnb) * 64, (it % nnb) * 64, lane_, a0, b0);
    while (it < nitems) {
        const int it1 = it + F.NGW, it2 = it1 + F.NGW;
        if (it1 < nitems) t8_load(W, N, (it1 / nnb) * 64, (it1 % nnb) * 64, lane_, a1, b1);
        t8_finish(a0, b0, T8_DST(it), ldd, scale, scr, lane_);
        if (it1 >= nitems) break;
        if (it2 < nitems) t8_load(W, N, (it2 / nnb) * 64, (it2 % nnb) * 64, lane_, a0, b0);
        t8_finish(a1, b1, T8_DST(it1), ldd, scale, scr, lane_);
        it = it2;
    }
#undef T8_DST
}
__device__ __forceinline__ void t16_load(const float* W, int N, int k0, int n0, int lane, f32x4 (&a)[8], f32x4 (&b)[8]) {
    const int kp = lane >> 4, nq = lane & 15;
#pragma unroll
    for (int it = 0; it < 8; ++it) { const float* p = W + (size_t)(k0 + 8 * it + 2 * kp) * N + n0 + 4 * nq; a[it] = __builtin_nontemporal_load((const f32x4*)p); b[it] = __builtin_nontemporal_load((const f32x4*)(p + N)); }
}
__device__ __forceinline__ void t16_finish(const f32x4 (&a)[8], const f32x4 (&b)[8], bf16_t* dst, int ldd, LAS unsigned* scr, int lane) {
    const int kp = lane >> 4, nq = lane & 15;
#pragma unroll
    for (int it = 0; it < 8; ++it)
#pragma unroll
        for (int e = 0; e < 4; ++e) scr[(4 * nq + e) * 33 + 4 * it + kp] = cvt_pk_bf16(a[it][e], b[it][e]);
    LDS_WAIT(); asm volatile("" ::: "memory");
    const int nr = lane >> 3, c = lane & 7;
#pragma unroll
    for (int ps = 0; ps < 8; ++ps) { const int n = 8 * ps + nr; u32x4 w; w.x = scr[n * 33 + 4 * c]; w.y = scr[n * 33 + 4 * c + 1]; w.z = scr[n * 33 + 4 * c + 2]; w.w = scr[n * 33 + 4 * c + 3];
        *(u32x4*)(dst + (size_t)n * ldd + 8 * c) = w; }
    LDS_WAIT(); asm volatile("" ::: "memory");
}
struct CvPtrs { const float *ret_in, *ret_out, *ffn_g, *ffn_u, *ffn_d, *na_in, *na_out, *xa_out, *memkv; unsigned char* ws; };
__device__ __forceinline__ void conv_all_p0(Frame& F, const CvPtrs P) {
    int tid_ = tid_now(F.wave); asm volatile("" : "+v"(tid_)); const int lane_ = tid_ & 63;
    LAS unsigned* scr = (LAS unsigned*)(F.lds + F.wave * 8448);
    constexpr int TOTAL = 6912;
#define CV_CASE(first_, src_, N__, nnb__, dstoff_, ld__, md__, ro__) if (j_ >= (first_)) { f_ = (first_); Wb_ = (src_); Nn_ = (N__); nb_ = (nnb__); db_ = (bf16_t*)(P.ws + (dstoff_)); ld_ = (ld__); md_ = (md__); ro_ = (ro__); }
#define CV_DECODE(jj_, W_, N_, k0_, n0_, dst_, ldd_) do { const int j_ = (jj_); int f_ = 0, Nn_ = 2048, nb_ = 32, ld_ = 4096, md_ = 0, ro_ = 0; const float* Wb_ = P.ret_out; bf16_t* db_ = (bf16_t*)(P.ws + WS_W_RETOUT); \
        CV_CASE(2048, P.ffn_d, 2048, 32, WS_W_FFND, FFN, 0, 0) CV_CASE(4864, P.na_out, 2048, 32, WS_W_NAOUT, 2048, 0, 0) \
        CV_CASE(5888, P.xa_out, 2048, 32, WS_W_XOT, 512, 0, 0) CV_CASE(6144, P.xa_out + 512 * 2048, 2048, 32, WS_W_XOT + (size_t)2048 * 512 * 2, 512, 0, 0) CV_CASE(6400, P.memkv, 1024, 16, WS_W_MEMKV, 2048, 0, 0) \
        const int r_ = j_ - f_, kb_ = r_ / nb_, nbi_ = r_ % nb_; W_ = Wb_; N_ = Nn_; k0_ = kb_ * 64; n0_ = nbi_ * 64; ldd_ = ld_; \
        dst_ = db_ + (size_t)(md_ ? ((n0_ >> 7) * 256 + (n0_ & 127) + ro_) : (ro_ + n0_)) * ld_ + k0_; } while (0)
    f32x4 a0[8], b0[8], a1[8], b1[8];
    const float* W0; const float* W1; int N0, N1, k0, k1, n0, n1, l0, l1; bf16_t* d0; bf16_t* d1;
    int j = F.gw;
    if (j < TOTAL) { CV_DECODE(j, W0, N0, k0, n0, d0, l0); t16_load(W0, N0, k0, n0, lane_, a0, b0); }
    while (j < TOTAL) {
        const int ja = j + F.NGW, jb = ja + F.NGW;
        if (ja < TOTAL) { CV_DECODE(ja, W1, N1, k1, n1, d1, l1); t16_load(W1, N1, k1, n1, lane_, a1, b1); }
        t16_finish(a0, b0, d0, l0, scr, lane_);
        if (ja >= TOTAL) break;
        if (jb < TOTAL) { CV_DECODE(jb, W0, N0, k0, n0, d0, l0); t16_load(W0, N0, k0, n0, lane_, a0, b0); }
        t16_finish(a1, b1, d1, l1, scr, lane_);
        j = jb;
    }
#undef CV_DECODE
#undef CV_CASE
}
__device__ __forceinline__ void colmax_item(const f32x4 (&a)[8], const f32x4 (&b)[8], unsigned* cmax_row0, int lane) {
    const int nq = lane & 15; f32x4 m = (f32x4){0.f, 0.f, 0.f, 0.f};
#pragma unroll
    for (int it = 0; it < 8; ++it)
#pragma unroll
        for (int e = 0; e < 4; ++e) m[e] = fmaxf(m[e], fmaxf(fabsf(a[it][e]), fabsf(b[it][e])));
#pragma unroll
    for (int e = 0; e < 4; ++e) { m[e] = fmaxf(m[e], __shfl_xor(m[e], 16)); m[e] = fmaxf(m[e], __shfl_xor(m[e], 32)); }
    if (lane < 16) {
#pragma unroll
        for (int e = 0; e < 4; ++e) atomicMax(cmax_row0 + 4 * nq + e, __float_as_uint(m[e])); }
}
__device__ __forceinline__ void q8_finish(const f32x4 (&a)[8], const f32x4 (&b)[8], unsigned char* dst, int ldd, const unsigned* cmax_row0, LAS unsigned* scr, int lane) {
    const int kq = lane >> 4, nq = lane & 15;
    const u32x4 cm = *(const u32x4*)(cmax_row0 + 4 * nq);
    const float inv[4] = {cm.x ? 127.0f / __uint_as_float(cm.x) : 0.f, cm.y ? 127.0f / __uint_as_float(cm.y) : 0.f, cm.z ? 127.0f / __uint_as_float(cm.z) : 0.f, cm.w ? 127.0f / __uint_as_float(cm.w) : 0.f};
#pragma unroll
    for (int it = 0; it < 4; ++it)
#pragma unroll
        for (int e = 0; e < 4; ++e) scr[(4 * nq + e) * 17 + 4 * it + kq] = pk4_i8((f32x4){a[2 * it][e], b[2 * it][e], a[2 * it + 1][e], b[2 * it + 1][e]}, inv[e]);
    LDS_WAIT(); asm volatile("" ::: "memory");
    const int nr = lane >> 2, c = lane & 3;
#pragma unroll
    for (int ps = 0; ps < 4; ++ps) { const int n = 16 * ps + nr; u32x4 w; w.x = scr[n * 17 + 4 * c]; w.y = scr[n * 17 + 4 * c + 1]; w.z = scr[n * 17 + 4 * c + 2]; w.w = scr[n * 17 + 4 * c + 3];
        *(u32x4*)(dst + (size_t)n * ldd + 16 * c) = w; }
    LDS_WAIT(); asm volatile("" ::: "memory");
}
template <bool QUANT>
__device__ __forceinline__ void i8_job(Frame& F, const float* W, int K, int N, unsigned char* W8, int ldd, int mode, int row_off, unsigned* cmax, int rot) {
    int tid_ = tid_now(F.wave); asm volatile("" : "+v"(tid_)); const int lane_ = tid_ & 63;
    LAS unsigned* scr = (LAS unsigned*)(F.lds + F.wave * 8448);
    const int nnb = N / 64, nitems = (K / 64) * nnb;
#define I8_ROW0(it_) (mode ? (((((it_) % nnb) * 64) >> 7) * 256 + ((((it_) % nnb) * 64) & 127) + row_off) : (row_off + ((it_) % nnb) * 64))
#define I8_DO(a_, b_, it_) do { if constexpr (QUANT) q8_finish(a_, b_, W8 + (size_t)I8_ROW0(it_) * ldd + ((it_) / nnb) * 64, ldd, cmax + I8_ROW0(it_), scr, lane_); else colmax_item(a_, b_, cmax + I8_ROW0(it_), lane_); } while (0)
    f32x4 a0[8], b0[8], a1[8], b1[8];
    int it = F.gw + rot; if (it >= F.NGW) it -= F.NGW;
    if (it < nitems) t8_load(W, N, (it / nnb) * 64, (it % nnb) * 64, lane_, a0, b0);
    while (it < nitems) {
        const int it1 = it + F.NGW, it2 = it1 + F.NGW;
        if (it1 < nitems) t8_load(W, N, (it1 / nnb) * 64, (it1 % nnb) * 64, lane_, a1, b1);
        I8_DO(a0, b0, it);
        if (it1 >= nitems) break;
        if (it2 < nitems) t8_load(W, N, (it2 / nnb) * 64, (it2 % nnb) * 64, lane_, a0, b0);
        I8_DO(a1, b1, it1);
        it = it2;
    }
#undef I8_DO
#undef I8_ROW0
}
__device__ __forceinline__ void quant_wqk(Frame& F, const bf16_t* WQK, unsigned char* WQ8, const unsigned* cmax) {
    int tid_ = tid_now(F.wave); asm volatile("" : "+v"(tid_)); const int lane_ = tid_ & 63;
    for (int rrow = F.gw; rrow < 2048; rrow += F.NGW) { const int L = rrow >> 10, n = rrow & 1023;
        const unsigned cm = cmax[rrow]; const float inv = cm ? 127.0f / __uint_as_float(cm) : 0.f;
        const u32x4* src = (const u32x4*)(WQK + (size_t)n * 4096 + L * 2048) + lane_;
        u32x2* dst = (u32x2*)(WQ8 + (size_t)rrow * 2048) + lane_;
#pragma unroll
        for (int j = 0; j < 4; ++j) { const u32x4 v = src[64 * j];
            u32x2 o; o.x = pk4_i8((f32x4){bf_lo(v.x), bf_hi(v.x), bf_lo(v.y), bf_hi(v.y)}, inv); o.y = pk4_i8((f32x4){bf_lo(v.z), bf_hi(v.z), bf_lo(v.w), bf_hi(v.w)}, inv);
            dst[64 * j] = o; } }
}
template <bool H16>
__device__ __forceinline__ void rms_row_i8(const void* xrow, const float* gain, unsigned char* orow, float* rs_row, int lane) {
    f32x4 v[8]; float s = 0.f;
#pragma unroll
    for (int j = 0; j < 8; ++j) { if constexpr (H16) v[j] = h4_to_f32(((const u32x2*)xrow + lane)[64 * j]); else v[j] = ((const f32x4*)xrow + lane)[64 * j]; s += (v[j][0] * v[j][0] + v[j][1] * v[j][1]) + (v[j][2] * v[j][2] + v[j][3] * v[j][3]); }
    const float rstd = 1.0f / sqrtf(wave_sum(s) * (1.0f / 2048.0f) + RMS_EPS);
    const f32x4* gr = (const f32x4*)gain + lane; float am = 0.f;
#pragma unroll
    for (int j = 0; j < 8; ++j) { v[j] = v[j] * rstd * gr[64 * j]; am = fmaxf(am, fmaxf(fmaxf(fabsf(v[j][0]), fabsf(v[j][1])), fmaxf(fabsf(v[j][2]), fabsf(v[j][3])))); }
    am = wave_max(am); const float inv = am > 0.f ? 127.0f / am : 0.f;
#pragma unroll
    for (int j = 0; j < 8; ++j) ((unsigned*)orow + lane)[64 * j] = pk4_i8(v[j], inv);
    if (lane == 0) *rs_row = am * (1.0f / 127.0f);
}
template <bool H16>
__device__ __forceinline__ void norm_phase_i8(Frame& F, const void* h, const float* gain, unsigned char* out, float* rs) {
    int tid_ = tid_now(F.wave); asm volatile("" : "+v"(tid_)); const int lane_ = tid_ & 63;
    for (int m = F.gw; m < T; m += F.NGW) rms_row_i8<H16>((const unsigned char*)h + (size_t)m * D * (H16 ? 2 : 4), gain, out + (size_t)m * D, rs + m, lane_);
}
__device__ __forceinline__ void moe_conv_slice(Frame& F, const float* wg, const float* wu, const float* wd, unsigned char* WGU, unsigned char* WD) {
    int tid_ = tid_now(F.wave); asm volatile("" : "+v"(tid_)); const int lane_ = tid_ & 63;
    LAS unsigned* scr = (LAS unsigned*)(F.lds + F.wave * 8448);
    constexpr int PER_E = 3 * 3584, TOTAL = NE * PER_E;
    int j0, j1;
    { const int b = (int)blockIdx.x, G = F.G; constexpr int LIGHT = 288;
      if (G > 8) { const int rest = TOTAL - 4 * LIGHT, q = rest / (G - 4), r = rest % (G - 4);
          if (b < 4) { j0 = b * LIGHT; j1 = j0 + LIGHT; } else { const int bb = b - 4; j0 = 4 * LIGHT + bb * q + (bb < r ? bb : r); j1 = j0 + q + (bb < r ? 1 : 0); } }
      else { const int q = TOTAL / G; j0 = b * q; j1 = (b == G - 1) ? TOTAL : j0 + q; } }
#define MC_DECODE(j_, W_, N_, k0_, n0_, dst_, ldd_) do { const int e_ = (j_) / PER_E, r_ = (j_) % PER_E, mat_ = r_ / 3584, rr_ = r_ % 3584; \
        if (mat_ < 2) { const int kb_ = rr_ / 112, nb_ = rr_ % 112; W_ = (mat_ ? wu : wg) + (size_t)e_ * 2048 * EDIM; N_ = EDIM; k0_ = kb_ * 64; n0_ = nb_ * 64; ldd_ = 2048; \
            dst_ = WGU + ((size_t)e_ * 2 * EDIM + (size_t)((n0_ >> 7) * 256 + (n0_ & 127) + mat_ * 128)) * 2048 + k0_; } \
        else { const int kb_ = rr_ / 32, nb_ = rr_ % 32; W_ = wd + (size_t)e_ * EDIM * 2048; N_ = 2048; k0_ = kb_ * 64; n0_ = nb_ * 64; ldd_ = EDIM; \
            dst_ = WD + ((size_t)e_ * 2048 + n0_) * EDIM + k0_; } } while (0)
    f32x4 a0[8], b0[8], a1[8], b1[8], a2[8], b2[8];
    const float* W0; const float* W1; const float* W2; int N0, N1, N2, k0, k1, k2, n0, n1, n2, l0, l1, l2; unsigned char* d0; unsigned char* d1; unsigned char* d2;
    int j = j0 + F.wave;
    if (j < j1) { MC_DECODE(j, W0, N0, k0, n0, d0, l0); t8_load(W0, N0, k0, n0, lane_, a0, b0); }
    if (j + 8 < j1) { MC_DECODE(j + 8, W1, N1, k1, n1, d1, l1); t8_load(W1, N1, k1, n1, lane_, a1, b1); }
    while (j < j1) {
        if (j + 16 < j1) { MC_DECODE(j + 16, W2, N2, k2, n2, d2, l2); t8_load(W2, N2, k2, n2, lane_, a2, b2); }
        t8_finish(a0, b0, d0, l0, 64.f, scr, lane_);
        if (j + 8 >= j1) break;
        if (j + 24 < j1) { MC_DECODE(j + 24, W0, N0, k0, n0, d0, l0); t8_load(W0, N0, k0, n0, lane_, a0, b0); }
        t8_finish(a1, b1, d1, l1, 64.f, scr, lane_);
        if (j + 16 >= j1) break;
        if (j + 32 < j1) { MC_DECODE(j + 32, W1, N1, k1, n1, d1, l1); t8_load(W1, N1, k1, n1, lane_, a1, b1); }
        t8_finish(a2, b2, d2, l2, 64.f, scr, lane_);
        j += 24;
    }
#undef MC_DECODE
    __syncthreads();
}
template <int OUT = 0  , bool H16 = false>
__device__ __forceinline__ void rms_row(const void* xrow, const float* gain, void* orow_, int lane, f32x4 (&v)[8]) {
    float s = 0.f;
#pragma unroll
    for (int j = 0; j < 8; ++j) { if constexpr (H16) v[j] = h4_to_f32(((const u32x2*)xrow + lane)[64 * j]); else v[j] = ((const f32x4*)xrow + lane)[64 * j]; s += (v[j][0] * v[j][0] + v[j][1] * v[j][1]) + (v[j][2] * v[j][2] + v[j][3] * v[j][3]); }
    const float rstd = 1.0f / sqrtf(wave_sum(s) * (1.0f / 2048.0f) + RMS_EPS);
    const f32x4* gr = (const f32x4*)gain + lane;
#pragma unroll
    for (int j = 0; j < 8; ++j) { const f32x4 g = gr[64 * j]; v[j] = v[j] * rstd * g;
        if constexpr (OUT == 0) { u32x2 w; w.x = cvt_pk_bf16(v[j][0], v[j][1]); w.y = cvt_pk_bf16(v[j][2], v[j][3]); ((u32x2*)orow_ + lane)[64 * j] = w; }
        else ((unsigned*)orow_ + lane)[64 * j] = pk4_fp8(v[j][0], v[j][1], v[j][2], v[j][3]); }
}
__device__ __forceinline__ void norm_phase(Frame& F, const float* h, const float* gain, bf16_t* out, int nrows) {
    int tid_ = tid_now(F.wave); asm volatile("" : "+v"(tid_)); const int lane_ = tid_ & 63;
    for (int m = F.gw; m < nrows; m += 2 * F.NGW) {
        const int m2 = m + F.NGW; const bool two = m2 < nrows;
        f32x4 v0[8], v1[8];
        const f32x4* x0 = (const f32x4*)(h + (size_t)m * D) + lane_; const f32x4* x1 = (const f32x4*)(h + (size_t)(two ? m2 : m) * D) + lane_;
#pragma unroll
        for (int j = 0; j < 8; ++j) v0[j] = x0[64 * j];
#pragma unroll
        for (int j = 0; j < 8; ++j) v1[j] = x1[64 * j];
        const f32x4* gr = (const f32x4*)gain + lane_;
        { float s = 0.f;
#pragma unroll
          for (int j = 0; j < 8; ++j) s += (v0[j][0] * v0[j][0] + v0[j][1] * v0[j][1]) + (v0[j][2] * v0[j][2] + v0[j][3] * v0[j][3]);
          const float rstd = 1.0f / sqrtf(wave_sum(s) * (1.0f / 2048.0f) + RMS_EPS); u32x2* o = (u32x2*)(out + (size_t)m * D) + lane_;
#pragma unroll
          for (int j = 0; j < 8; ++j) { const f32x4 r = v0[j] * rstd * gr[64 * j]; u32x2 w; w.x = cvt_pk_bf16(r[0], r[1]); w.y = cvt_pk_bf16(r[2], r[3]); o[64 * j] = w; } }
        if (two) { float s = 0.f;
#pragma unroll
          for (int j = 0; j < 8; ++j) s += (v1[j][0] * v1[j][0] + v1[j][1] * v1[j][1]) + (v1[j][2] * v1[j][2] + v1[j][3] * v1[j][3]);
          const float rstd = 1.0f / sqrtf(wave_sum(s) * (1.0f / 2048.0f) + RMS_EPS); u32x2* o = (u32x2*)(out + (size_t)m2 * D) + lane_;
#pragma unroll
          for (int j = 0; j < 8; ++j) { const f32x4 r = v1[j] * rstd * gr[64 * j]; u32x2 w; w.x = cvt_pk_bf16(r[0], r[1]); w.y = cvt_pk_bf16(r[2], r[3]); o[64 * j] = w; } }
    }
}
__device__ __forceinline__ void scan_phase(Frame& F, bf16_t* BS, const float* decay_logit) {
    int tid_ = tid_now(F.wave); asm volatile("" : "+v"(tid_)); const int lane_ = tid_ & 63;
    const int dir = lane_ >> 5;
    for (int w = F.gw; w < RH * RDV; w += F.NGW) {
        const int h = w >> 9, dv = w & 511;
        const float dch = __builtin_amdgcn_exp2f(log2_decay(decay_logit, dir, h) * 256.0f);
        bf16_t* p0 = BS + (((size_t)h * 64) * 512 + dv) * 768 + 256 + lane_ * 8;
        const size_t cstride = (size_t)512 * 768;
        float s[8];
#pragma unroll
        for (int e = 0; e < 8; ++e) s[e] = 0.f;
#pragma unroll 1
        for (int t0 = 0; t0 < 64; t0 += 8) {
            u32x4 v[8];
#pragma unroll
            for (int q = 0; q < 8; ++q) { const int i = dir ? 63 - (t0 + q) : (t0 + q); v[q] = *(const u32x4*)(p0 + (size_t)i * cstride); }
#pragma unroll
            for (int q = 0; q < 8; ++q) { const int i = dir ? 63 - (t0 + q) : (t0 + q);
                u32x4 o; o.x = cvt_pk_bf16(s[0], s[1]); o.y = cvt_pk_bf16(s[2], s[3]); o.z = cvt_pk_bf16(s[4], s[5]); o.w = cvt_pk_bf16(s[6], s[7]);
                *(u32x4*)(p0 + (size_t)i * cstride) = o;
                s[0] = dch * s[0] + bf_lo(v[q].x); s[1] = dch * s[1] + bf_hi(v[q].x); s[2] = dch * s[2] + bf_lo(v[q].y); s[3] = dch * s[3] + bf_hi(v[q].y);
                s[4] = dch * s[4] + bf_lo(v[q].z); s[5] = dch * s[5] + bf_hi(v[q].z); s[6] = dch * s[6] + bf_lo(v[q].w); s[7] = dch * s[7] + bf_hi(v[q].w); }
        }
    }
}
__device__ __forceinline__ void groupnorm_phase(Frame& F, const bf16_t* YRAW, bf16_t* GB, const float* gn_gain) {
    int tid_ = tid_now(F.wave); asm volatile("" : "+v"(tid_)); const int lane_ = tid_ & 63;
    const int h = F.gw & 7;
    const f32x4 g0 = *((const f32x4*)(gn_gain + h * 512) + 2 * lane_), g1 = *((const f32x4*)(gn_gain + h * 512) + 2 * lane_ + 1);
    const float gn[8] = {g0[0], g0[1], g0[2], g0[3], g1[0], g1[1], g1[2], g1[3]};
    for (int p0 = F.gw; p0 < T * RH; p0 += 4 * F.NGW) {
        u32x4 yv[4], gv[4];
#pragma unroll
        for (int q = 0; q < 4; ++q) { const int p = p0 + q * F.NGW; const int pc = p < T * RH ? p : p0; yv[q] = *((const u32x4*)(YRAW + (size_t)pc * 512) + lane_); gv[q] = *((const u32x4*)(GB + (size_t)pc * 512) + lane_); }
#pragma unroll
        for (int q = 0; q < 4; ++q) { const int p = p0 + q * F.NGW; if (p >= T * RH) break;
            float y[8] = {bf_lo(yv[q].x), bf_hi(yv[q].x), bf_lo(yv[q].y), bf_hi(yv[q].y), bf_lo(yv[q].z), bf_hi(yv[q].z), bf_lo(yv[q].w), bf_hi(yv[q].w)};
            float s = 0.f;
#pragma unroll
            for (int e = 0; e < 8; ++e) s += y[e];
            const float mu = wave_sum(s) * (1.0f / 512.0f); float qq = 0.f;
#pragma unroll
            for (int e = 0; e < 8; ++e) { y[e] -= mu; qq += y[e] * y[e]; }
            const float rstd = 1.0f / sqrtf(wave_sum(qq) * (1.0f / 512.0f) + GN_EPS);
            const float gg[8] = {bf_lo(gv[q].x), bf_hi(gv[q].x), bf_lo(gv[q].y), bf_hi(gv[q].y), bf_lo(gv[q].z), bf_hi(gv[q].z), bf_lo(gv[q].w), bf_hi(gv[q].w)};
#pragma unroll
            for (int e = 0; e < 8; ++e) y[e] = y[e] * rstd * gn[e] * gg[e];
            u32x4 o; o.x = cvt_pk_bf16(y[0], y[1]); o.y = cvt_pk_bf16(y[2], y[3]); o.z = cvt_pk_bf16(y[4], y[5]); o.w = cvt_pk_bf16(y[6], y[7]);
            *((u32x4*)(GB + (size_t)p * 512) + lane_) = o; }
    }
}
__device__ __forceinline__ void na_phase(Frame& F, const bf16_t* NQ, const bf16_t* NK, const bf16_t* NVT, bf16_t* NATT, const float* rpb) {
    int tid_ = tid_now(F.wave); asm volatile("" : "+v"(tid_)); const int lane_ = tid_ & 63;
    LAS float* rp = (LAS float*)F.lds;
    for (int i = tid_; i < NAH * 15 * 31; i += 512) rp[i] = rpb[i];
    __syncthreads();
    const int fr = lane_ & 15, fq = lane_ >> 4;
#define NA_LOADK(kf, batch) do { _Pragma("unroll") for (int bi = 0; bi < 4; ++bi) { const int b_ = (batch) * 4 + bi; \
        const bf16_t* kp_ = kbase + (size_t)(b_ >> 1) * 8192 + (b_ & 1) * 512; \
        _Pragma("unroll") for (int kk = 0; kk < 4; ++kk) kf[bi][kk] = *(const bf16x8*)(kp_ + kk * 128); } } while (0)
#define NA_MMAK(kf, batch) do { _Pragma("unroll") for (int bi = 0; bi < 4; ++bi) { f32x4 a_ = (f32x4){0.f, 0.f, 0.f, 0.f}; \
        _Pragma("unroll") for (int kk = 0; kk < 4; ++kk) a_ = __builtin_amdgcn_mfma_f32_16x16x32_bf16(kf[bi][kk], qf[kk], a_, 0, 0, 0); s[(batch) * 4 + bi] = a_; } } while (0)
#define NA_LOADV(vf, dd) do { const bf16_t* vr_ = vbase + (dd) * 128; \
        _Pragma("unroll") for (int bb = 0; bb < 8; ++bb) vf[bb] = *(const u32x4*)(vr_ + bb * 8192); } while (0)
#define NA_MMAV(vf, dd) do { f32x4 o_ = (f32x4){0.f, 0.f, 0.f, 0.f}; \
        _Pragma("unroll") for (int bb = 0; bb < 8; ++bb) o_ = __builtin_amdgcn_mfma_f32_16x16x32_bf16(__builtin_bit_cast(bf16x8, vf[bb]), pf[bb], o_, 0, 0, 0); \
        u32x2 w_; w_.x = cvt_pk_bf16(o_[0] * inv, o_[1] * inv); w_.y = cvt_pk_bf16(o_[2] * inv, o_[3] * inv); *(u32x2*)(obase + (dd) * 16) = w_; } while (0)
    for (int t = F.gw; t < T; t += F.NGW) {
        const int g = t & 3, h = (t >> 2) & 15, r = t >> 6;
        const int rs = min(max(r - 4, 0), 248);
        const int c0 = g == 0 ? 0 : (g == 1 ? 8 : (g == 2 ? 24 : 32));
        const int qc = 16 * g + fr, qtok = r * 64 + qc;
        const int cs = min(max(qc - 8, 0), 48);
        const bf16_t* kbase = NK + (size_t)h * T * 128 + (size_t)(((rs * 64 + c0) >> 3) + (fr >> 2)) * 1024 + fq * 32 + (fr & 3) * 8;
        const bf16_t* vbase = NVT + (size_t)h * T * 128 + ((size_t)(((rs * 64 + c0) >> 3) + fq) * 128 + fr) * 8;
        bf16_t* obase = NATT + (size_t)qtok * 2048 + h * 128 + 4 * fq;
        bf16x8 qf[4];
#pragma unroll
        for (int kk = 0; kk < 4; ++kk) qf[kk] = *(const bf16x8*)(NQ + (size_t)qtok * 2048 + h * 128 + kk * 32 + fq * 8);
        f32x4 s[16];
        {
            bf16x8 kA[4][4], kB[4][4];
            NA_LOADK(kA, 0); NA_LOADK(kB, 1); __builtin_amdgcn_sched_barrier(0);
            NA_MMAK(kA, 0); __builtin_amdgcn_sched_barrier(0);
            NA_LOADK(kA, 2); __builtin_amdgcn_sched_barrier(0);
            NA_MMAK(kB, 1); __builtin_amdgcn_sched_barrier(0);
            NA_LOADK(kB, 3); __builtin_amdgcn_sched_barrier(0);
            NA_MMAK(kA, 2); __builtin_amdgcn_sched_barrier(0);
            NA_MMAK(kB, 3);
        }
        u32x4 vA[8], vB[8];
        NA_LOADV(vA, 0); NA_LOADV(vB, 1);
        float mx = -3.0e38f;
#pragma unroll
        for (int b = 0; b < 16; ++b) { const int dr = rs + (b >> 1) - r;
#pragma unroll
            for (int e = 0; e < 4; ++e) { const int kc = c0 + 8 * fq + (b & 1) * 4 + e; const bool ok = (kc >= cs) && (kc < cs + 16);
                const int dc = ok ? kc - qc : 0;
                const float bias = rp[h * 465 + (dr + 7) * 31 + dc + 15];
                const float v = ok ? s[b][e] + bias : -3.0e38f; s[b][e] = v; mx = fmaxf(mx, v); } }
        mx = fmaxf(mx, __shfl_xor(mx, 16)); mx = fmaxf(mx, __shfl_xor(mx, 32));
        float sum = 0.f;
#pragma unroll
        for (int b = 0; b < 16; ++b)
#pragma unroll
            for (int e = 0; e < 4; ++e) { const float q = s[b][e] > -1.0e38f ? fast_exp(s[b][e] - mx) : 0.f; s[b][e] = q; sum += q; }
        sum += __shfl_xor(sum, 16); sum += __shfl_xor(sum, 32);
        const float inv = __builtin_amdgcn_rcpf(sum);
        bf16x8 pf[8];
#pragma unroll
        for (int bb = 0; bb < 8; ++bb) { u32x4 w; w.x = cvt_pk_bf16(s[2 * bb][0], s[2 * bb][1]); w.y = cvt_pk_bf16(s[2 * bb][2], s[2 * bb][3]);
            w.z = cvt_pk_bf16(s[2 * bb + 1][0], s[2 * bb + 1][1]); w.w = cvt_pk_bf16(s[2 * bb + 1][2], s[2 * bb + 1][3]); pf[bb] = __builtin_bit_cast(bf16x8, w); }
        __builtin_amdgcn_sched_barrier(0);
        NA_MMAV(vA, 0); __builtin_amdgcn_sched_barrier(0); NA_LOADV(vA, 2); __builtin_amdgcn_sched_barrier(0);
        NA_MMAV(vB, 1); __builtin_amdgcn_sched_barrier(0); NA_LOADV(vB, 3); __builtin_amdgcn_sched_barrier(0);
        NA_MMAV(vA, 2); __builtin_amdgcn_sched_barrier(0); NA_LOADV(vA, 4); __builtin_amdgcn_sched_barrier(0);
        NA_MMAV(vB, 3); __builtin_amdgcn_sched_barrier(0); NA_LOADV(vB, 5); __builtin_amdgcn_sched_barrier(0);
        NA_MMAV(vA, 4); __builtin_amdgcn_sched_barrier(0); NA_LOADV(vA, 6); __builtin_amdgcn_sched_barrier(0);
        NA_MMAV(vB, 5); __builtin_amdgcn_sched_barrier(0); NA_LOADV(vB, 7); __builtin_amdgcn_sched_barrier(0);
        NA_MMAV(vA, 6); __builtin_amdgcn_sched_barrier(0);
        NA_MMAV(vB, 7);
    }
#undef NA_LOADK
#undef NA_MMAK
#undef NA_LOADV
#undef NA_MMAV
    __syncthreads();
}
__device__ __forceinline__ void moe_tile_starts(Frame& F, const unsigned* ctl, volatile LAS unsigned* ts) {
    int tid_ = tid_now(F.wave); asm volatile("" : "+v"(tid_)); const int lane_ = tid_ & 63;
    if (tid_ == 0) { unsigned a = 0; for (int e = 0; e < 8; ++e) { ts[e] = a; a += (ctl[CW_CNT + e] + 255u) >> 8; } ts[8] = a; }
    __syncthreads();
}
__device__ __forceinline__ void router_phase(Frame& F, unsigned* ctl, const h16_t* h, const float* gain, const float* wrouter, unsigned char* HN8, int* list_tok, unsigned* tokinfo) {
    int tid_ = tid_now(F.wave); asm volatile("" : "+v"(tid_)); const int lane_ = tid_ & 63;
    LAS float* wl = (LAS float*)F.lds;
    LAS int* selE = (LAS int*)(F.lds + 65536); LAS float* selW = (LAS float*)(F.lds + 65536 + 512); LAS int* rank = (LAS int*)(F.lds + 65536 + 1024); LAS int* base = (LAS int*)(F.lds + 65536 + 1536);
    for (int i = tid_; i < 2048 * 8; i += 512) { const int k = i >> 3, e = i & 7; wl[e * 2048 + k] = wrouter[i]; }
    __syncthreads();
    for (int rb = blockIdx.x; rb < T / 64; rb += F.G) {
#pragma unroll 1
        for (int q = 0; q < 8; ++q) {
            const int lr = F.wave * 8 + q, tok = rb * 64 + lr;
            f32x4 v[8]; rms_row<1, true>(h + (size_t)tok * D, gain, HN8 + (size_t)tok * D, lane_, v);
            float lg[8];
#pragma unroll
            for (int e = 0; e < 8; ++e) { float a = 0.f;
#pragma unroll
                for (int j = 0; j < 8; ++j) { const f32x4 w = *((const LAS f32x4*)(wl + e * 2048) + 64 * j + lane_); a += (v[j][0] * w[0] + v[j][1] * w[1]) + (v[j][2] * w[2] + v[j][3] * w[3]); }
                lg[e] = wave_sum(a); }
            int e1 = 0; float v1 = lg[0];
#pragma unroll
            for (int e = 1; e < 8; ++e) if (lg[e] > v1) { v1 = lg[e]; e1 = e; }
            int e2 = -1; float v2 = -3.0e38f;
#pragma unroll
            for (int e = 0; e < 8; ++e) if (e != e1 && lg[e] > v2) { v2 = lg[e]; e2 = e; }
            const float ex = expf(v2 - v1); const float w1 = 1.0f / (1.0f + ex), w2 = ex / (1.0f + ex);
            if (lane_ == 0) { selE[lr * 2] = e1; selE[lr * 2 + 1] = e2; selW[lr * 2] = w1; selW[lr * 2 + 1] = w2; }
        }
        __syncthreads();
        if (tid_ < 8) { int c = 0; for (int a = 0; a < 128; ++a) if (selE[a] == tid_) { rank[a] = c; ++c; }
            base[tid_] = c ? (int)atomicAdd(ctl + CW_CNT + tid_, (unsigned)c) : 0; }
        __syncthreads();
        if (tid_ < 128) { const int a = tid_, e = selE[a], pos = base[e] + rank[a], tok = rb * 64 + (a >> 1);
            list_tok[e * T + pos] = tok; tokinfo[tok * 4 + (a & 1)] = (unsigned)(e * T + pos); tokinfo[tok * 4 + 2 + (a & 1)] = __float_as_uint(selW[a]); }
        __syncthreads();
    }
}
__device__ __forceinline__ void gather_phase(Frame& F, const unsigned* ctl, const unsigned char* HN, const int* list_tok, unsigned char* XG, volatile LAS unsigned* ts) {
    int tid_ = tid_now(F.wave); asm volatile("" : "+v"(tid_)); const int lane_ = tid_ & 63;
    const int nrows = (int)ts[8] * 256;
    int tsv[8], cnt[8];
#pragma unroll
    for (int j = 0; j < 8; ++j) { tsv[j] = (int)ts[j]; cnt[j] = (int)ctl[CW_CNT + j]; }
    for (int s0 = F.gw * 16; s0 < nrows; s0 += F.NGW * 16) {
        const int rt = s0 >> 8; int e = 0, tbase = 0, ce = cnt[0];
#pragma unroll
        for (int j = 1; j < 8; ++j) if (tsv[j] <= rt) { e = j; tbase = tsv[j]; ce = cnt[j]; }
        const int pos = s0 + (lane_ & 15) - tbase * 256;
        const int tok = pos < ce ? list_tok[e * T + pos] : -1;
        u32x4 va[16], vb[16];
#pragma unroll
        for (int r = 0; r < 16; ++r) { const int tr = __builtin_amdgcn_readlane(tok, r); const u32x4* src = (const u32x4*)(HN + (size_t)(tr < 0 ? 0 : tr) * D) + lane_;
            va[r] = src[0]; vb[r] = src[64]; if (tr < 0) { va[r] = (u32x4){0u, 0u, 0u, 0u}; vb[r] = (u32x4){0u, 0u, 0u, 0u}; } }
#pragma unroll
        for (int r = 0; r < 16; ++r) { u32x4* dst = (u32x4*)(XG + (size_t)(s0 + r) * D) + lane_; dst[0] = va[r]; dst[64] = vb[r]; }
    }
}
__device__ __forceinline__ void add_expert_row(const bf16_t* Y, const bf16_t* YP, int slot, int tail_row0, float w, int lane, f32x4 (&v)[8]) {
    if (slot < tail_row0) { const u32x2* y = (const u32x2*)(Y + (size_t)slot * D) + lane; u32x2 a[8];
#pragma unroll
        for (int j = 0; j < 8; ++j) a[j] = y[64 * j];
#pragma unroll
        for (int j = 0; j < 8; ++j) { v[j][0] += w * bf_lo(a[j].x); v[j][1] += w * bf_hi(a[j].x); v[j][2] += w * bf_lo(a[j].y); v[j][3] += w * bf_hi(a[j].y); } }
    else {
#pragma unroll 1
        for (int q = 0; q < 4; ++q) { const u32x2* y = (const u32x2*)(YP + ((size_t)q * 2048 + (size_t)(slot - tail_row0)) * D) + lane; u32x2 a[8];
#pragma unroll
            for (int j = 0; j < 8; ++j) a[j] = y[64 * j];
#pragma unroll
            for (int j = 0; j < 8; ++j) { v[j][0] += w * bf_lo(a[j].x); v[j][1] += w * bf_hi(a[j].x); v[j][2] += w * bf_lo(a[j].y); v[j][3] += w * bf_hi(a[j].y); } } }
}
__device__ __forceinline__ void final_phase(Frame& F, const h16_t* hin, float* hout, const bf16_t* Y, const bf16_t* YP, const int tail_row0, const unsigned* tokinfo, const float* gain, volatile LAS unsigned* ts) {
    int tid_ = tid_now(F.wave); asm volatile("" : "+v"(tid_)); const int lane_ = tid_ & 63;
    int tsv[8];
#pragma unroll
    for (int j = 0; j < 8; ++j) tsv[j] = (int)ts[j];
#define FIN_TS(e_) ((e_) == 0 ? tsv[0] : (e_) == 1 ? tsv[1] : (e_) == 2 ? tsv[2] : (e_) == 3 ? tsv[3] : (e_) == 4 ? tsv[4] : (e_) == 5 ? tsv[5] : (e_) == 6 ? tsv[6] : tsv[7])
    const f32x4* gr = (const f32x4*)gain + lane_;
    for (int tok0 = F.gw; tok0 < T; tok0 += 2 * F.NGW) {
        const int tok1 = tok0 + F.NGW < T ? tok0 + F.NGW : tok0;
        const u32x4 i0 = *(const u32x4*)(tokinfo + tok0 * 4), i1 = *(const u32x4*)(tokinfo + tok1 * 4);
        const int sa0 = FIN_TS((int)(i0.x >> 14)) * 256 + (int)(i0.x & 16383), sb0 = FIN_TS((int)(i0.y >> 14)) * 256 + (int)(i0.y & 16383);
        const int sa1 = FIN_TS((int)(i1.x >> 14)) * 256 + (int)(i1.x & 16383), sb1 = FIN_TS((int)(i1.y >> 14)) * 256 + (int)(i1.y & 16383);
        const float wa0 = __uint_as_float(i0.z), wb0 = __uint_as_float(i0.w), wa1 = __uint_as_float(i1.z), wb1 = __uint_as_float(i1.w);
        f32x4* h0 = (f32x4*)(hout + (size_t)tok0 * D) + lane_; f32x4* h1 = (f32x4*)(hout + (size_t)tok1 * D) + lane_;
        const u32x2* g0 = (const u32x2*)(hin + (size_t)tok0 * D) + lane_; const u32x2* g1 = (const u32x2*)(hin + (size_t)tok1 * D) + lane_;
        f32x4 v0[8], v1[8];
        const int smax = max(max(sa0, sb0), max(sa1, sb1));
        if (__builtin_amdgcn_readfirstlane(smax) < tail_row0) {
            const u32x2* ya0 = (const u32x2*)(Y + (size_t)sa0 * D) + lane_; const u32x2* yb0 = (const u32x2*)(Y + (size_t)sb0 * D) + lane_;
            const u32x2* ya1 = (const u32x2*)(Y + (size_t)sa1 * D) + lane_; const u32x2* yb1 = (const u32x2*)(Y + (size_t)sb1 * D) + lane_;
            u32x2 a0[8], b0[8], a1[8], b1[8];
#pragma unroll
            for (int j = 0; j < 8; ++j) { v0[j] = h4_to_f32(g0[64 * j]); a0[j] = ya0[64 * j]; b0[j] = yb0[64 * j]; }
#pragma unroll
            for (int j = 0; j < 8; ++j) { v1[j] = h4_to_f32(g1[64 * j]); a1[j] = ya1[64 * j]; b1[j] = yb1[64 * j]; }
#pragma unroll
            for (int j = 0; j < 8; ++j) { v0[j][0] += wa0 * bf_lo(a0[j].x) + wb0 * bf_lo(b0[j].x); v0[j][1] += wa0 * bf_hi(a0[j].x) + wb0 * bf_hi(b0[j].x); v0[j][2] += wa0 * bf_lo(a0[j].y) + wb0 * bf_lo(b0[j].y); v0[j][3] += wa0 * bf_hi(a0[j].y) + wb0 * bf_hi(b0[j].y);
                v1[j][0] += wa1 * bf_lo(a1[j].x) + wb1 * bf_lo(b1[j].x); v1[j][1] += wa1 * bf_hi(a1[j].x) + wb1 * bf_hi(b1[j].x); v1[j][2] += wa1 * bf_lo(a1[j].y) + wb1 * bf_lo(b1[j].y); v1[j][3] += wa1 * bf_hi(a1[j].y) + wb1 * bf_hi(b1[j].y); }
        } else {
#pragma unroll
            for (int j = 0; j < 8; ++j) { v0[j] = h4_to_f32(g0[64 * j]); v1[j] = h4_to_f32(g1[64 * j]); }
            add_expert_row(Y, YP, sa0, tail_row0, wa0, lane_, v0); add_expert_row(Y, YP, sb0, tail_row0, wb0, lane_, v0);
            add_expert_row(Y, YP, sa1, tail_row0, wa1, lane_, v1); add_expert_row(Y, YP, sb1, tail_row0, wb1, lane_, v1);
        }
        { float s = 0.f;
#pragma unroll
          for (int j = 0; j < 8; ++j) s += (v0[j][0] * v0[j][0] + v0[j][1] * v0[j][1]) + (v0[j][2] * v0[j][2] + v0[j][3] * v0[j][3]);
          const float rstd = 1.0f / sqrtf(wave_sum(s) * (1.0f / 2048.0f) + RMS_EPS);
#pragma unroll
          for (int j = 0; j < 8; ++j) h0[64 * j] = v0[j] * rstd * gr[64 * j]; }
        if (tok1 != tok0) { float s = 0.f;
#pragma unroll
          for (int j = 0; j < 8; ++j) s += (v1[j][0] * v1[j][0] + v1[j][1] * v1[j][1]) + (v1[j][2] * v1[j][2] + v1[j][3] * v1[j][3]);
          const float rstd = 1.0f / sqrtf(wave_sum(s) * (1.0f / 2048.0f) + RMS_EPS);
#pragma unroll
          for (int j = 0; j < 8; ++j) h1[64 * j] = v1[j] * rstd * gr[64 * j]; }
    }
#undef FIN_TS
}

__device__ __forceinline__ const void* karg(int byte_off) {
    unsigned long long p; asm volatile("s_load_dwordx2 %0, %1, %2\n\ts_waitcnt lgkmcnt(0)" : "=s"(p) : "s"(__builtin_amdgcn_kernarg_segment_ptr()), "n"(byte_off) : "memory");
    return (const void*)(__attribute__((address_space(1))) const char*)p; }
#define INP(k) ((const float*)karg((k) * 8))
#define OUTP() ((float*)karg(176))
#define WSB() ((unsigned char*)karg(184))
#define WP(off) ((bf16_t*)(ws + (off)))

__global__ void __launch_bounds__(512, 2) fwd_kernel(Args args) {
    extern __shared__ __attribute__((aligned(16))) unsigned char lds_raw[];
    Frame F;
    F.lds = (LAS unsigned char*)lds_raw; F.MISC = (volatile LAS unsigned*)(F.lds + MISC_OFF);
    F.wave = __builtin_amdgcn_readfirstlane((int)threadIdx.x >> 6);
    F.G = gridDim.x; F.gw = blockIdx.x * 8 + F.wave; F.NGW = F.G * 8;
    for (int u = threadIdx.x; u < (LDS_BYTES - MISC_OFF) / 4; u += 512) ((LAS unsigned*)(F.lds + MISC_OFF))[u] = 0u;
    __syncthreads();
    XcdBarrier bar = xcd_barrier_post((unsigned*)(args.ws + WS_CTL) + CW_BAR, F.MISC + 8);
    volatile LAS unsigned* ts = F.MISC + 16;

    pg8::Order S;
    const int cblk = (int)blockIdx.x;
#define ORDER(nM, nN, rot) S.init((nM), (nN), F.G, (cblk + (rot)) % F.G)

    if (PH(0)) REPLOOP(0) {
        unsigned char* ws = WSB();
        i8_job<false>(F, INP(5), 2048, 12288, nullptr, 0, 0, 0, (unsigned*)(ws + CTL_CMAX_RET), 0);
        { CvPtrs P{INP(5), INP(6), INP(9), INP(10), INP(11), INP(12), INP(13), INP(20), INP(3), ws}; conv_all_p0(F, P); }
        i8_job<false>(F, INP(9), 2048, FFN, nullptr, 0, 1, 0, (unsigned*)(ws + CTL_CMAX_FFN), 0);
        i8_job<false>(F, INP(10), 2048, FFN, nullptr, 0, 1, 128, (unsigned*)(ws + CTL_CMAX_FFN), 768);
        i8_job<false>(F, INP(12), 2048, 6144, nullptr, 0, 0, 0, (unsigned*)(ws + CTL_CMAX_NA), 1536);
        { const float* xa_w_q = INP(19); bf16_t* W_XQ = WP(WS_W_XQ);
          for (int i = F.gw * 64 + (tid_now(F.wave) & 63); i < 2 * 2048 * 512 / 4; i += F.NGW * 64) { const f32x4 v = ((const f32x4*)xa_w_q)[i]; u32x2 w; w.x = cvt_pk_bf16(v[0], v[1]); w.y = cvt_pk_bf16(v[2], v[3]); ((u32x2*)W_XQ)[i] = w; } }
        { bf16_t* MEMK = WP(WS_MEMK);
          for (int i = F.gw * 64 + (tid_now(F.wave) & 63); i < 2 * 1024 * 512 * 2 / 16; i += F.NGW * 64) ((u32x4*)MEMK)[i] = (u32x4){0u, 0u, 0u, 0u}; }
        norm_phase_i8<false>(F, INP(0), INP(4) + 0 * D, ws + WS_HN, (float*)(ws + WS_RS));
        norm_phase(F, INP(1), INP(2), WP(WS_MEMN), NMEM);
    }
    xcd_barrier(bar, tid_now(F.wave) == 0);
    if (PH(26)) REPLOOP(26) { unsigned char* ws = WSB(); i8_job<true>(F, INP(5), 2048, 12288, ws + WS_W_RETIN, 2048, 0, 0, (unsigned*)(ws + CTL_CMAX_RET), 0); }
    xcd_barrier(bar, tid_now(F.wave) == 0);
    if (PH(1)) REPLOOP(1) {
        unsigned char* ws = WSB(); const float* decay_logit = INP(7);
        const unsigned char* HN8 = ws + WS_HN; const unsigned char* W8 = ws + WS_W_RETIN;
        const float* rs = (const float*)(ws + WS_RS); const unsigned* cmx = (const unsigned*)(ws + CTL_CMAX_RET);
        const int slot = (cblk >> 3) % 13;
#define CONV_SLICE() moe_conv_slice(F, INP(16), INP(17), INP(18), ws + WS_W_MOEGU, ws + WS_W_MOED)
#pragma unroll 1
        for (int seg = 0; seg < 2; ++seg) { const int cut = min(max(slot - 0, 0), 4);
            if (SB(0)) { ORDER(64, 16, 0); S.i0 = seg ? cut : 0; S.i1 = seg ? 4 : cut; MapAB8 mp{HN8, W8, (size_t)256 * 2048, (size_t)256 * 2048}; EpiRetQK8 E{WP(WS_QB), WP(WS_KB), WP(WS_AP), WP(WS_KZ), decay_logit, rs, cmx}; pg8::gemm_phase<3>(F.lds, F.wave, S, mp, 2048, 2048, 2048, E); }
            if (seg == 0 && slot >= 0 && slot < 4) CONV_SLICE(); }
#pragma unroll 1
        for (int seg = 0; seg < 2; ++seg) { const int cut = min(max(slot - 4, 0), 4);
            if (SB(1)) { ORDER(64, 16, 0); S.i0 = seg ? cut : 0; S.i1 = seg ? 4 : cut; MapAB8 mp{HN8, W8 + (size_t)8192 * 2048, (size_t)256 * 2048, (size_t)256 * 2048}; EpiSilu8i E{WP(WS_GB), rs, cmx + 8192}; pg8::gemm_phase<3>(F.lds, F.wave, S, mp, 2048, 2048, 2048, E); }
            if (seg == 0 && slot >= 4 && slot < 8) CONV_SLICE(); }
#pragma unroll 1
        for (int seg = 0; seg < 2; ++seg) { const int cut = min(max(slot - 8, 0), 4);
            if (SB(3)) { ORDER(16, 64, 0); S.i0 = seg ? cut : 0; S.i1 = seg ? 4 : cut; MapAB8 mp{W8 + (size_t)4096 * 2048, HN8, (size_t)256 * 2048, (size_t)256 * 2048}; EpiRetV8 E{WP(WS_BS), rs, cmx}; pg8::gemm_phase<3>(F.lds, F.wave, S, mp, 2048, 2048, 2048, E); }
            if (seg == 0 && slot >= 8 && slot < 12) CONV_SLICE(); }
        if (slot == 12) CONV_SLICE();
#undef CONV_SLICE
        if (SB(4)) { ORDER(1, 4, 0); MapAB mp{WP(WS_MEMN), WP(WS_W_MEMKV), 0, (size_t)256 * 2048}; EpiMemKV E{WP(WS_MEMK), WP(WS_MEMV)}; pg8::gemm_phase(F.lds, F.wave, S, mp, 2048, 2048, 2048, E); }
    }
    xcd_barrier(bar, tid_now(F.wave) == 0);
    if (PH(2)) REPLOOP(2) {
        unsigned char* ws = WSB(); const float* decay_logit = INP(7);
        if (SB(5)) { ORDER(512, 1, 0); MapRetS mp{WP(WS_QB), WP(WS_KB)}; EpiRetScores E{WP(WS_AP), decay_logit}; pg8::gemm_phase(F.lds, F.wave, S, mp, 256, 2048, 2048, E); }
        if (SB(6)) { ORDER(1024, 2, 0); MapRetKV mp{WP(WS_BS), WP(WS_KZ)}; EpiStore<AdRetKV> E{{WP(WS_BS)}}; pg8::gemm_phase(F.lds, F.wave, S, mp, 256, 768, T, E); }
        if (SB(7)) { ORDER(4, 16, 0); MapAB mp{WP(WS_MEMK), WP(WS_W_XQ), (size_t)256 * 512, (size_t)256 * 512}; EpiWqk E{WP(WS_W_QK), (unsigned*)(ws + CTL_CMAX_QK), 0.08838834764831845f}; pg8::gemm_phase(F.lds, F.wave, S, mp, 512, 512, 512, E); }
        if (SB(8)) { ORDER(16, 4, 64); MapAB mp{WP(WS_W_XOT), WP(WS_MEMV), (size_t)256 * 512, (size_t)256 * 512}; EpiStore<AdSimple> E{{WP(WS_W_VO), 1024, 1.f, 256}}; pg8::gemm_phase(F.lds, F.wave, S, mp, 512, 512, 512, E); }
    }
    xcd_barrier(bar, tid_now(F.wave) == 0);
    if (PH(3)) REPLOOP(3) { unsigned char* ws = WSB(); scan_phase(F, WP(WS_BS), INP(7));
        quant_wqk(F, WP(WS_W_QK), ws + WS_W_XQ, (const unsigned*)(ws + CTL_CMAX_QK));
        i8_job<true>(F, INP(12), 2048, 6144, ws + WS_W_NAIN, 2048, 0, 0, (unsigned*)(ws + CTL_CMAX_NA), 0);
        i8_job<true>(F, INP(9), 2048, FFN, ws + WS_W_FFNGU, 2048, 1, 0, (unsigned*)(ws + CTL_CMAX_FFN), 1024);
        i8_job<true>(F, INP(10), 2048, FFN, ws + WS_W_FFNGU, 2048, 1, 128, (unsigned*)(ws + CTL_CMAX_FFN), 1792); }
    xcd_barrier(bar, tid_now(F.wave) == 0);
    if (PH(4)) REPLOOP(4) { unsigned char* ws = WSB();
        if (SB(9)) { ORDER(512, 2, 0); MapRetO mp{WP(WS_AP), WP(WS_BS)}; EpiStore<AdRetY> E{{WP(WS_YRAW)}}; pg8::gemm_phase(F.lds, F.wave, S, mp, 768, 768, 768, E); } }
    xcd_barrier(bar, tid_now(F.wave) == 0);
    if (PH(5)) REPLOOP(5) {
        unsigned char* ws = WSB();
        groupnorm_phase(F, WP(WS_YRAW), WP(WS_GB), INP(8));
    }
    xcd_barrier(bar, tid_now(F.wave) == 0);
    if (PH(6)) REPLOOP(6) { unsigned char* ws = WSB();
        if (SB(10)) { ORDER(64, 8, 0); MapAB mp{WP(WS_GB), WP(WS_W_RETOUT), (size_t)256 * 4096, (size_t)256 * 4096}; EpiResidH<true> E{INP(0), (h16_t*)(ws + WS_H16)}; pg8::gemm_phase(F.lds, F.wave, S, mp, 4096, 4096, 4096, E); } }
    xcd_barrier(bar, tid_now(F.wave) == 0);
    if (PH(7)) REPLOOP(7) { unsigned char* ws = WSB(); norm_phase_i8<true>(F, ws + WS_H16, INP(4) + 1 * D, ws + WS_HN, (float*)(ws + WS_RS)); }
    xcd_barrier(bar, tid_now(F.wave) == 0);
    if (PH(8)) REPLOOP(8) { unsigned char* ws = WSB();
        if (SB(11)) { ORDER(64, 4, 0); MapAB8 mp{ws + WS_HN, ws + WS_W_XQ, (size_t)256 * 2048, (size_t)256 * 2048}; EpiXaSoftmax E{WP(WS_XP), F.lds + EXCH_OFF, (const float*)(ws + WS_RS), (const unsigned*)(ws + CTL_CMAX_QK)}; pg8::gemm_phase<3>(F.lds, F.wave, S, mp, 2048, 2048, 2048, E); } }
    xcd_barrier(bar, tid_now(F.wave) == 0);
    if (PH(9)) REPLOOP(9) { unsigned char* ws = WSB(); h16_t* hbuf = (h16_t*)(ws + WS_H16);
        if (SB(12)) { ORDER(64, 8, 0); MapAB mp{WP(WS_XP), WP(WS_W_VO), (size_t)256 * 1024, (size_t)256 * 1024}; EpiResidH<false> E{hbuf, hbuf}; pg8::gemm_phase(F.lds, F.wave, S, mp, 1024, 1024, 1024, E); } }
    xcd_barrier(bar, tid_now(F.wave) == 0);
    if (PH(10)) REPLOOP(10) { unsigned char* ws = WSB(); norm_phase_i8<true>(F, ws + WS_H16, INP(4) + 2 * D, ws + WS_HN, (float*)(ws + WS_RS)); }
    xcd_barrier(bar, tid_now(F.wave) == 0);
    if (PH(11)) REPLOOP(11) { unsigned char* ws = WSB();
        if (SB(13)) { ORDER(64, 44, 0); MapAB8 mp{ws + WS_HN, ws + WS_W_FFNGU, (size_t)256 * 2048, (size_t)256 * 2048}; EpiSwiglu8i E{WP(WS_FHID), FFN, (const float*)(ws + WS_RS), (const unsigned*)(ws + CTL_CMAX_FFN)}; pg8::gemm_phase<3>(F.lds, F.wave, S, mp, 2048, 2048, 2048, E); } }
    xcd_barrier(bar, tid_now(F.wave) == 0);
    if (PH(12)) REPLOOP(12) { unsigned char* ws = WSB(); h16_t* hbuf = (h16_t*)(ws + WS_H16);
        if (SB(14)) { ORDER(64, 8, 0); MapAB mp{WP(WS_FHID), WP(WS_W_FFND), (size_t)256 * FFN, (size_t)256 * FFN}; EpiResidH<false> E{hbuf, hbuf}; pg8::gemm_phase(F.lds, F.wave, S, mp, FFN, FFN, FFN, E); } }
    xcd_barrier(bar, tid_now(F.wave) == 0);
    if (PH(13)) REPLOOP(13) { unsigned char* ws = WSB(); norm_phase_i8<true>(F, ws + WS_H16, INP(4) + 3 * D, ws + WS_HN, (float*)(ws + WS_RS)); }
    xcd_barrier(bar, tid_now(F.wave) == 0);
    if (PH(14)) REPLOOP(14) { unsigned char* ws = WSB(); const unsigned char* HN8 = ws + WS_HN; const unsigned char* W8 = ws + WS_W_NAIN;
        const float* rs = (const float*)(ws + WS_RS); const unsigned* cmx = (const unsigned*)(ws + CTL_CMAX_NA);
        if (SB(15)) { ORDER(64, 16, 0); MapAB8 mp{HN8, W8, (size_t)256 * 2048, (size_t)256 * 2048}; EpiNaQK8 E{WP(WS_NQ), WP(WS_NK), rs, cmx}; pg8::gemm_phase<3>(F.lds, F.wave, S, mp, 2048, 2048, 2048, E); }
        if (SB(16)) { ORDER(8, 64, 0); MapAB8 mp{W8 + (size_t)4096 * 2048, HN8, (size_t)256 * 2048, (size_t)256 * 2048}; EpiNaV8 E{WP(WS_NVT), rs, cmx}; pg8::gemm_phase<3>(F.lds, F.wave, S, mp, 2048, 2048, 2048, E); }
    }
    xcd_barrier(bar, tid_now(F.wave) == 0);
    if (PH(15)) REPLOOP(15) { unsigned char* ws = WSB(); na_phase(F, WP(WS_NQ), WP(WS_NK), WP(WS_NVT), WP(WS_NATT), INP(14)); }
    xcd_barrier(bar, tid_now(F.wave) == 0);
    if (PH(16)) REPLOOP(16) { unsigned char* ws = WSB(); h16_t* hbuf = (h16_t*)(ws + WS_H16);
        if (SB(17)) { ORDER(64, 8, 0); MapAB mp{WP(WS_NATT), WP(WS_W_NAOUT), (size_t)256 * 2048, (size_t)256 * 2048}; EpiResidH<false> E{hbuf, hbuf}; pg8::gemm_phase(F.lds, F.wave, S, mp, 2048, 2048, 2048, E); } }
    xcd_barrier(bar, tid_now(F.wave) == 0);
    if (PH(17)) REPLOOP(17) { unsigned char* ws = WSB(); norm_phase_i8<true>(F, ws + WS_H16, INP(4) + 4 * D, ws + WS_HN, (float*)(ws + WS_RS)); }
    xcd_barrier(bar, tid_now(F.wave) == 0);
    if (PH(18)) REPLOOP(18) { unsigned char* ws = WSB();
        if (SB(18)) { ORDER(64, 4, 0); MapAB8 mp{ws + WS_HN, ws + WS_W_XQ + (size_t)1024 * 2048, (size_t)256 * 2048, (size_t)256 * 2048}; EpiXaSoftmax E{WP(WS_XP), F.lds + EXCH_OFF, (const float*)(ws + WS_RS), (const unsigned*)(ws + CTL_CMAX_QK) + 1024}; pg8::gemm_phase<3>(F.lds, F.wave, S, mp, 2048, 2048, 2048, E); } }
    xcd_barrier(bar, tid_now(F.wave) == 0);
    if (PH(19)) REPLOOP(19) { unsigned char* ws = WSB(); h16_t* hbuf = (h16_t*)(ws + WS_H16);
        if (SB(19)) { ORDER(64, 8, 0); MapAB mp{WP(WS_XP), WP(WS_W_VO) + (size_t)2048 * 1024, (size_t)256 * 1024, (size_t)256 * 1024}; EpiResidH<false> E{hbuf, hbuf}; pg8::gemm_phase(F.lds, F.wave, S, mp, 1024, 1024, 1024, E); } }
    xcd_barrier(bar, tid_now(F.wave) == 0);
    if (PH(20)) REPLOOP(20) { unsigned char* ws = WSB(); router_phase(F, (unsigned*)(ws + WS_CTL), (const h16_t*)(ws + WS_H16), INP(4) + 5 * D, INP(15), ws + WS_HN8, (int*)(ws + WS_LIST), (unsigned*)(ws + WS_TOKINFO)); }
    xcd_barrier(bar, tid_now(F.wave) == 0);
    if (PH(21)) REPLOOP(21) { unsigned char* ws = WSB(); moe_tile_starts(F, (unsigned*)(ws + WS_CTL), ts); gather_phase(F, (unsigned*)(ws + WS_CTL), ws + WS_HN8, (int*)(ws + WS_LIST), ws + WS_XG, ts); }
    xcd_barrier(bar, tid_now(F.wave) == 0);
    if (PH(22)) REPLOOP(22) { unsigned char* ws = WSB();
        if (SB(20)) { ORDER(__builtin_amdgcn_readfirstlane((int)ts[8]), 56, 0); MapMoe mp{ws + WS_XG, ws + WS_W_MOEGU, (size_t)256 * 2048, (size_t)2 * EDIM * 2048, (size_t)256 * 2048, ts}; EpiSwiglu8 E{ws + WS_MHID, EDIM}; pg8::gemm_phase<1>(F.lds, F.wave, S, mp, 2048, 2048, 2048, E); } }
    xcd_barrier(bar, tid_now(F.wave) == 0);
    if (PH(23)) REPLOOP(23) { unsigned char* ws = WSB();
        if (SB(21)) { pg8::OrderTail ST; ST.init(__builtin_amdgcn_readfirstlane((int)ts[8]), F.G, cblk); MapMoeD mp{ws + WS_MHID, ws + WS_W_MOED, ts}; EpiMoeDown E{WP(WS_XG), WP(WS_YP), ST.split ? (ST.tail_tile0() >> 3) * 256 : 0};
                      pg8::gemm_phase<1>(F.lds, F.wave, ST, mp, EDIM, EDIM, EDIM, E); } }
    xcd_barrier(bar, tid_now(F.wave) == 0);
    if (PH(24)) REPLOOP(24) { unsigned char* ws = WSB(); pg8::OrderTail ST; ST.init(__builtin_amdgcn_readfirstlane((int)ts[8]), F.G, cblk);
        final_phase(F, (const h16_t*)(ws + WS_H16), OUTP(), WP(WS_XG), WP(WS_YP), ST.split ? (ST.tail_tile0() >> 3) * 256 : 0x7fffffff, (unsigned*)(ws + WS_TOKINFO), INP(21), ts); }
#undef ORDER
}

extern "C" void kernel_launch(void* const* d_in, const int* in_sizes, int n_in, void* d_out, int out_size, void* d_ws, size_t ws_size, hipStream_t stream) {
    static int grid = 0;
    if (grid == 0) {
        if (n_in != 22 || out_size != T * D || ws_size < WS_END) { fprintf(stderr, "kernel_launch: unexpected shapes (n_in %d, out %d, ws %zu < %zu)\n", n_in, out_size, ws_size, (size_t)WS_END); grid = -1; return; }
        int dev = 0, cus = 0, per_cu = 0;
        if (hipGetDevice(&dev) != hipSuccess || hipDeviceGetAttribute(&cus, hipDeviceAttributeMultiprocessorCount, dev) != hipSuccess) { grid = -1; return; }
        if (hipFuncSetAttribute((const void*)fwd_kernel, hipFuncAttributeMaxDynamicSharedMemorySize, LDS_BYTES) != hipSuccess) { fprintf(stderr, "kernel_launch: hipFuncSetAttribute failed\n"); grid = -1; return; }
        if (hipOccupancyMaxActiveBlocksPerMultiprocessor(&per_cu, (const void*)fwd_kernel, 512, LDS_BYTES) != hipSuccess || per_cu < 1) { fprintf(stderr, "kernel_launch: occupancy query says %d blocks per CU\n", per_cu); }
        (void)hipGetLastError();
        grid = cus;
    }
    if (grid < 0) return;
    (void)in_sizes;
    if (hipMemsetAsync((char*)d_ws + WS_CTL, 0, CTL_ZERO_BYTES, stream) != hipSuccess) return;
    Args a{};
    for (int i = 0; i < 22; ++i) a.in[i] = (const float*)d_in[i];
    a.out = (float*)d_out; a.ws = (unsigned char*)d_ws;
    hipLaunchKernelGGL(fwd_kernel, dim3(grid), dim3(512), LDS_BYTES, stream, a);
}
```
